# Optimizing an MI355X kernel written in HIP

```python
import math
import jax, jax.numpy as jnp
from jax import lax
import numpy as np


D_MODEL = 1024
BATCH = 8
SEQ = 4096
DEPTH = 1

N_HEADS_SWA = 8
N_KV_HEADS_SWA = 2
N_HEADS_FOX = 8
HEAD_DIM = 64
WINDOW = 128
BLOCK = 128
NUM_BUCKETS = 32
MAX_DISTANCE = 128
N_GROUPS = 4
EXPERTS_PER_GROUP = 8
TOP_K = 2
D_FF_EXPERT = 256
FORGET_BIAS_INIT = 2.0
EPS = 1e-6
NEG_INF = -1e30

Q_A = N_HEADS_SWA * HEAD_DIM
KV_A = N_KV_HEADS_SWA * HEAD_DIM
W_B = N_HEADS_FOX * HEAD_DIM
IN_SPLITS = (Q_A, KV_A, KV_A, W_B, W_B, W_B, N_HEADS_FOX, 2 * D_MODEL)
IN_COLS = Q_A + 2 * KV_A + 3 * W_B + N_HEADS_FOX + 2 * D_MODEL

kernel_name = "hybrid_swa_sink_fox_hmoe_adaln_block"


def _rmsnorm(x, g):
    x32 = x.astype(jnp.float32)
    y = x32 * lax.rsqrt(jnp.mean(x32 * x32, axis=-1, keepdims=True) + EPS)
    return (y * g.astype(jnp.float32)).astype(x.dtype)


def _modulate(h, shift, scale):
    return h * (1 + scale[:, None, :]) + shift[:, None, :]


def _t5_bucket(dist):
    n = jnp.maximum(dist, 0)
    max_exact = NUM_BUCKETS // 2
    nf = jnp.maximum(n, 1).astype(jnp.float32)
    large = max_exact + (jnp.log(nf / max_exact) / math.log(MAX_DISTANCE / max_exact)
                         * (NUM_BUCKETS - max_exact)).astype(jnp.int32)
    large = jnp.minimum(large, NUM_BUCKETS - 1)
    return jnp.where(n < max_exact, n, large)


def _sliding_window_attention(q, k, v, sinks, rel_table):
    b, s, _ = q.shape
    nb = s // BLOCK
    grp = N_HEADS_SWA // N_KV_HEADS_SWA
    qb = q.reshape(b, nb, BLOCK, N_KV_HEADS_SWA, grp, HEAD_DIM)
    k = k.reshape(b, s, N_KV_HEADS_SWA, HEAD_DIM)
    v = v.reshape(b, s, N_KV_HEADS_SWA, HEAD_DIM)
    pad = ((0, 0), (BLOCK, 0), (0, 0), (0, 0))
    kp = jnp.pad(k, pad)
    vp = jnp.pad(v, pad)
    shp = (b, nb, BLOCK, N_KV_HEADS_SWA, HEAD_DIM)
    kb = jnp.concatenate([kp[:, :s].reshape(shp), kp[:, BLOCK:].reshape(shp)], axis=2)
    vb = jnp.concatenate([vp[:, :s].reshape(shp), vp[:, BLOCK:].reshape(shp)], axis=2)
    scores = jnp.einsum('bnqhgd,bnkhd->bnhgqk', qb, kb).astype(jnp.float32) * (HEAD_DIM ** -0.5)
    qi = jnp.arange(BLOCK)[:, None]
    kj = jnp.arange(2 * BLOCK)[None, :]
    dist = qi - kj + BLOCK
    band = (dist >= 0) & (dist < WINDOW)
    key_pos = jnp.arange(nb)[:, None, None] * BLOCK - BLOCK + kj[None]
    valid = band[None] & (key_pos >= 0)
    bias = rel_table[_t5_bucket(dist)].astype(jnp.float32)
    bias = jnp.transpose(bias, (2, 0, 1)).reshape(N_KV_HEADS_SWA, grp, BLOCK, 2 * BLOCK)
    scores = jnp.where(valid[None, :, None, None], scores + bias, NEG_INF)
    sink = jnp.broadcast_to(sinks.astype(jnp.float32).reshape(N_KV_HEADS_SWA, grp, 1, 1),
                            scores.shape[:-1] + (1,))
    probs = jax.nn.softmax(jnp.concatenate([scores, sink], axis=-1), axis=-1)[..., :-1]
    out = jnp.einsum('bnhgqk,bnkhd->bnqhgd', probs.astype(v.dtype), vb)
    return out.reshape(b, s, Q_A)


def _forgetting_attention(q, k, v, f_logit, b_forget):
    b, s, _ = q.shape
    nb = s // BLOCK
    q = q.reshape(b, s, N_HEADS_FOX, HEAD_DIM)
    k = k.reshape(b, s, N_HEADS_FOX, HEAD_DIM)
    v = v.reshape(b, s, N_HEADS_FOX, HEAD_DIM)
    log_f = jax.nn.log_sigmoid(f_logit.astype(jnp.float32) + b_forget.astype(jnp.float32))
    cum = jnp.cumsum(log_f, axis=1)
    cum_k = jnp.transpose(cum, (0, 2, 1))[:, :, None, :]
    qb = q.reshape(b, nb, BLOCK, N_HEADS_FOX, HEAD_DIM).transpose(1, 0, 2, 3, 4)
    cqb = cum.reshape(b, nb, BLOCK, N_HEADS_FOX).transpose(1, 0, 3, 2)
    kpos = jnp.arange(s)
    scale = HEAD_DIM ** -0.5

    def block(args):
        idx, qblk, cq = args
        sc = jnp.einsum('bqhd,bkhd->bhqk', qblk, k).astype(jnp.float32) * scale
        sc = sc + cq[..., None] - cum_k
        qpos = idx * BLOCK + jnp.arange(BLOCK)
        causal = kpos[None, :] <= qpos[:, None]
        p = jax.nn.softmax(jnp.where(causal, sc, NEG_INF), axis=-1)
        return jnp.einsum('bhqk,bkhd->bqhd', p.astype(v.dtype), v)

    out = lax.map(block, (jnp.arange(nb), qb, cqb))
    return out.transpose(1, 0, 2, 3, 4).reshape(b, s, W_B)


def _hierarchical_moe(h, w_rg, b_rg, w_re, b_re, w_g, w_u, w_d):
    bsz, s, d = h.shape
    t = h.reshape(-1, d)
    g_logits = (t @ w_rg + b_rg).astype(jnp.float32)
    g_prob = jax.nn.softmax(g_logits, axis=-1)
    gp, gi = lax.top_k(g_prob, 1)
    e_logits = (jnp.einsum('nd,gde->nge', t, w_re) + b_re).astype(jnp.float32)
    e_sel = jnp.take_along_axis(e_logits, gi[:, :, None], axis=1)[:, 0]
    ev, ei = lax.top_k(e_sel, TOP_K)
    ew = jax.nn.softmax(ev, axis=-1) * gp
    within = jnp.sum(jax.nn.one_hot(ei, EXPERTS_PER_GROUP, dtype=jnp.float32) * ew[..., None], axis=1)
    combine = jax.nn.one_hot(gi[:, 0], N_GROUPS, dtype=jnp.float32)[:, :, None] * within[:, None, :]
    y = jnp.zeros_like(t)
    for g in range(N_GROUPS):
        a = jnp.einsum('nd,edf->nef', t, w_g[g])
        u = jnp.einsum('nd,edf->nef', t, w_u[g])
        hid = jax.nn.silu(a) * u * combine[:, g, :, None].astype(t.dtype)
        y = y + jnp.einsum('nef,efd->nd', hid, w_d[g])
    return y.reshape(bsz, s, d)


def setup_inputs(seed: int = 0) -> dict:
    key = jax.random.key(seed)
    ks = jax.random.split(key, 22)

    def nrm(k, shape, scale):
        return jax.random.normal(k, shape, jnp.float32) * scale

    D, G, E, F = D_MODEL, N_GROUPS, EXPERTS_PER_GROUP, D_FF_EXPERT
    return {
        "x": nrm(ks[0], (BATCH, SEQ, D), 1.0),
        "c": nrm(ks[1], (BATCH, D), 1.0),
        "w_ada": nrm(ks[2], (DEPTH, D, 6 * D), 0.5 * D ** -0.5),
        "b_ada": nrm(ks[3], (DEPTH, 6 * D), 0.02),
        "g_norm_mix": 1.0 + nrm(ks[4], (DEPTH, D), 0.05),
        "g_norm_ffn": 1.0 + nrm(ks[5], (DEPTH, D), 0.05),
        "w_in": nrm(ks[6], (DEPTH, D, IN_COLS), D ** -0.5),
        "sinks": nrm(ks[7], (DEPTH, N_HEADS_SWA), 0.5),
        "b_forget": FORGET_BIAS_INIT + nrm(ks[8], (DEPTH, N_HEADS_FOX), 0.5),
        "w_proj_swa": nrm(ks[9], (DEPTH, Q_A, D), Q_A ** -0.5),
        "w_proj_fox": nrm(ks[10], (DEPTH, W_B, D), W_B ** -0.5),
        "w_out": nrm(ks[11], (DEPTH, D, D), D ** -0.5),
        "rel_bias_table": nrm(ks[12], (NUM_BUCKETS, N_HEADS_SWA), 0.5),
        "w_router_group": nrm(ks[13], (DEPTH, D, G), D ** -0.5),
        "b_router_group": nrm(ks[14], (DEPTH, G), 0.01),
        "w_router_expert": nrm(ks[15], (DEPTH, G, D, E), D ** -0.5),
        "b_router_expert": nrm(ks[16], (DEPTH, G, E), 0.01),
        "w_gate_exp": nrm(ks[17], (DEPTH, G, E, D, F), D ** -0.5),
        "w_up_exp": nrm(ks[18], (DEPTH, G, E, D, F), D ** -0.5),
        "w_down_exp": nrm(ks[19], (DEPTH, G, E, F, D), F ** -0.5),
        "g_final": 1.0 + nrm(ks[20], (D,), 0.05),
    }


def reference(x, c, w_ada, b_ada, g_norm_mix, g_norm_ffn, w_in, sinks, b_forget,
              w_proj_swa, w_proj_fox, w_out, rel_bias_table, w_router_group, b_router_group,
              w_router_expert, b_router_expert, w_gate_exp, w_up_exp, w_down_exp, g_final):
    offsets = []
    acc = 0
    for n in IN_SPLITS[:-1]:
        acc += n
        offsets.append(acc)
    c_act = jax.nn.silu(c)
    for l in range(DEPTH):
        mod = c_act @ w_ada[l] + b_ada[l]
        shift_m, scale_m, gate_m, shift_f, scale_f, gate_f = jnp.split(mod, 6, axis=-1)

        h = _modulate(_rmsnorm(x, g_norm_mix[l]), shift_m, scale_m)
        proj = h @ w_in[l]
        qa, ka, va, qb, kb, vb, f_logit, gates = jnp.split(proj, offsets, axis=-1)
        o_a = _sliding_window_attention(qa, ka, va, sinks[l], rel_bias_table)
        o_b = _forgetting_attention(qb, kb, vb, f_logit, b_forget[l])
        gate_a = jax.nn.sigmoid(gates[..., :D_MODEL])
        gate_b = jax.nn.sigmoid(gates[..., D_MODEL:])
        merged = gate_a * (o_a @ w_proj_swa[l]) + gate_b * (o_b @ w_proj_fox[l])
        x = x + gate_m[:, None, :] * (merged @ w_out[l])

        h2 = _modulate(_rmsnorm(x, g_norm_ffn[l]), shift_f, scale_f)
        y = _hierarchical_moe(h2, w_router_group[l], b_router_group[l], w_router_expert[l],
                              b_router_expert[l], w_gate_exp[l], w_up_exp[l], w_down_exp[l])
        x = x + gate_f[:, None, :] * y
    return _rmsnorm(x, g_final)
```

```cpp
#include <hip/hip_runtime.h>
#include <hip/hip_bf16.h>
#include <cstdio>
#include <cstdint>
#include <cmath>

#define LAS __attribute__((address_space(3)))
#define GAS __attribute__((address_space(1)))

constexpr int BATCH = 8, SEQ = 4096, D = 1024, M = BATCH * SEQ;
constexpr int IN_COLS = 4360, NPROJ = 4352;
constexpr int PP = 2304;
constexpr int C_QA = 0, C_KA = 512, C_VA = 640, C_QB = 768, C_KB = 1280, C_VB = 1792;
constexpr int NE = 32, FF = 256, LCAP = 32768, MAXPAN = 288;
constexpr float LOG2E = 1.4426950408889634f;
constexpr float C2 = 0.125f * LOG2E;
constexpr float EPS = 1e-6f;
constexpr int NWAVES = 8;
#ifndef PROBE_MASK
#define PROBE_MASK 0
#endif
#define REPS(k) (((PROBE_MASK >> (k)) & 1) ? 2 : 1)

constexpr size_t MiB = 1u << 20;
constexpr size_t WS_CTL = 0, CTL_ZERO_BYTES = 1 * MiB;
constexpr size_t WS_MOD = 1 * MiB;
constexpr size_t WS_LOGF = 2 * MiB;
constexpr size_t WS_CUM = 3 * MiB;
constexpr size_t WS_SWAT = 4 * MiB;
constexpr size_t WS_TOKL = 5 * MiB;
constexpr size_t WS_WL = 9 * MiB;
constexpr size_t WS_WIN = 16 * MiB;
constexpr size_t WS_WPA = 25 * MiB, WS_WPB = 26 * MiB, WS_WOUT = 27 * MiB;
constexpr size_t WS_WGU = 32 * MiB;
constexpr size_t WS_WD = 64 * MiB;
constexpr size_t WS_H = 80 * MiB;
constexpr size_t WS_R = 144 * MiB, WS_GB = 208 * MiB;
constexpr size_t WS_Y2 = 144 * MiB;
constexpr size_t WS_P = 272 * MiB;
constexpr size_t WS_X1 = 272 * MiB;
constexpr size_t WS_HID = 416 * MiB;
constexpr size_t WS_MGP = 416 * MiB;
constexpr int MGP = 1088;
constexpr size_t WS_DUMMY = 500 * MiB;
constexpr size_t WS_END = 501 * MiB;
constexpr int CW_CNT = 64;
constexpr int CW_BAR = 4096;
constexpr int CW_NRM = 3072;
constexpr int CW_QH = 3500;

constexpr int RING_OFF = 0, RING_BYTES = 131072;
constexpr int X_OFF = 147456;
constexpr int MOE_CNT_OFF = X_OFF, MOE_PB_OFF = X_OFF + 128, MOE_TOK_OFF = X_OFF + 512;
constexpr int P5_PE_OFF = X_OFF + 512, P5_PW_OFF = P5_PE_OFF + 1024, P5_LC_OFF = P5_PW_OFF + 1024, P5_GB_OFF = P5_LC_OFF + 128, P5_LG_OFF = P5_GB_OFF + 128, P5_FA_OFF = P5_LG_OFF + 5120, P5_FB_OFF = P5_FA_OFF + 4096;
constexpr int MISC_OFF = 163840 - 128;
constexpr int LDS_BYTES = 163840;
static_assert(P5_FB_OFF + 4096 <= MISC_OFF && MOE_TOK_OFF + 15 * 1024 <= MISC_OFF, "LDS map");

typedef unsigned short bf16;
typedef unsigned v4u __attribute__((ext_vector_type(4)));
typedef unsigned v2u __attribute__((ext_vector_type(2)));
typedef float f32x4 __attribute__((ext_vector_type(4)));
typedef GAS unsigned gu32;
#define RLX_AGENT __ATOMIC_RELAXED, __HIP_MEMORY_SCOPE_AGENT
#define LDS_WAIT() asm volatile("s_waitcnt lgkmcnt(0)" ::: "memory")
#define VM_WAIT() asm volatile("s_waitcnt vmcnt(0)" ::: "memory")
__device__ __forceinline__ unsigned f2bf(float f) { unsigned u = __builtin_bit_cast(unsigned, f); return (u + 0x7fffu + ((u >> 16) & 1u)) >> 16; }
__device__ __forceinline__ unsigned pk2(float lo, float hi) { return f2bf(lo) | (f2bf(hi) << 16); }
__device__ __forceinline__ float bflo(unsigned w) { return __builtin_bit_cast(float, w << 16); }
__device__ __forceinline__ float bfhi(unsigned w) { return __builtin_bit_cast(float, w & 0xffff0000u); }
__device__ __forceinline__ float fast_exp2(float x) { return __builtin_amdgcn_exp2f(x); }
__device__ __forceinline__ float fast_rcp(float x) { return __builtin_amdgcn_rcpf(x); }
__device__ __forceinline__ float sigmoidf_fast(float z) { return fast_rcp(1.f + fast_exp2(-z * LOG2E)); }
typedef float f32x2v __attribute__((ext_vector_type(2)));
__device__ __forceinline__ float dpp_f(float x, int ctrl) {
    switch (ctrl) {
    case 0xB1:  return __builtin_bit_cast(float, __builtin_amdgcn_update_dpp(0, __builtin_bit_cast(int, x), 0xB1, 0xF, 0xF, true));
    case 0x4E:  return __builtin_bit_cast(float, __builtin_amdgcn_update_dpp(0, __builtin_bit_cast(int, x), 0x4E, 0xF, 0xF, true));
    case 0x141: return __builtin_bit_cast(float, __builtin_amdgcn_update_dpp(0, __builtin_bit_cast(int, x), 0x141, 0xF, 0xF, true));
    default:    return __builtin_bit_cast(float, __builtin_amdgcn_update_dpp(0, __builtin_bit_cast(int, x), 0x140, 0xF, 0xF, true));
    }
}
__device__ __forceinline__ float wave_sum(float v) {
    v += dpp_f(v, 0xB1); v += dpp_f(v, 0x4E); v += dpp_f(v, 0x141); v += dpp_f(v, 0x140);
    { auto rr = __builtin_amdgcn_permlane16_swap(__float_as_uint(v), __float_as_uint(v), false, false); v = __uint_as_float(rr[0]) + __uint_as_float(rr[1]); }
    { auto rr = __builtin_amdgcn_permlane32_swap(__float_as_uint(v), __float_as_uint(v), false, false); v = __uint_as_float(rr[0]) + __uint_as_float(rr[1]); }
    return v;
}

namespace pg8 {
#define PG8_LAS __attribute__((address_space(3)))
typedef unsigned short bf16_t;
typedef short bf16x8 __attribute__((ext_vector_type(8)));
typedef float f32x4 __attribute__((ext_vector_type(4)));
typedef unsigned u32x4 __attribute__((ext_vector_type(4)));
constexpr int BM = 256, BK = 64, HALF = 128, HTB = HALF * BK * 2, STAGE_BYTES = 8 * HTB, NXCD = 8, WGM = 8;

__host__ __device__ __forceinline__ int lds_byte(int r, int c) { const int st = (r >> 4) * 2 + (c >> 5), rr = r & 15, cc = c & 31, ob = rr * 64 + cc * 2; return st * 1024 + (ob ^ (((ob >> 9) & 1) << 5)); }
__host__ __device__ __forceinline__ void stage_rc(int b, int& R, int& C) { const int st = b / 1024, sb = b % 1024, swz = sb ^ (((sb >> 9) & 1) << 5); R = (st >> 1) * 16 + swz / 64; C = (st & 1) * 32 + (swz % 64) / 2; }
__host__ __device__ __forceinline__ int perm32(int rho) { const int n = rho >> 4, i = rho & 15; return 8 * (i >> 2) + 4 * n + (i & 3); }

struct Unit { int pm, pn, e, seg, li, kind; };

struct StaticOrder {
    int nM, nN, nwg, G, c;
    __host__ __device__ void init(int M_, int N_, int G_, int c_) { nM = M_ / BM; nN = N_ / BM; nwg = nM * nN; G = G_; c = c_; }
    __host__ __device__ bool next(int i, Unit& u) const {
        const long L = (long)i * G + c; if (L >= nwg) return false;
        int wgid = (int)L; { const int q = nwg / NXCD, r = nwg % NXCD, xcd = wgid % NXCD, off = wgid / NXCD; wgid = (xcd < r ? xcd * (q + 1) : r * (q + 1) + (xcd - r) * q) + off; }
        const int nig = WGM * nN, gid = wgid / nig, fm = gid * WGM, gsz = (nM - fm) < WGM ? (nM - fm) : WGM;
        u.pm = fm + ((wgid % nig) % gsz); u.pn = (wgid % nig) / gsz; u.e = 0; u.seg = 0; u.li = i; u.kind = 0; return true;
    }
};
struct SegOrder {
    StaticOrder base;
    __device__ bool next(int i, Unit& u) const { if (!base.next(i >> 1, u)) return false; u.seg = i & 1; u.li = i; return true; }
};
struct MoeOrder {
    const PG8_LAS int* pbase; int nNsh, G, c;
    __device__ bool next(int i, Unit& u) const {
        const int x = c & 7, W = G >> 3; const int L = i * W + (c >> 3);
        int np[4], cp = 0;
#pragma unroll
        for (int k = 0; k < 4; ++k) { np[k] = __builtin_amdgcn_readfirstlane(pbase[x + 8 * k + 1]) - __builtin_amdgcn_readfirstlane(pbase[x + 8 * k]); cp += np[k]; }
        if (L >= (cp << nNsh)) return false;
        int lp = L >> nNsh; u.pn = L & ((1 << nNsh) - 1);
        int k = 0; if (lp >= np[0]) { lp -= np[0]; k = 1; if (lp >= np[1]) { lp -= np[1]; k = 2; if (lp >= np[2]) { lp -= np[2]; k = 3; } } }
        u.e = x + 8 * k; u.seg = lp; u.pm = __builtin_amdgcn_readfirstlane(pbase[u.e]) + lp; u.li = i; u.kind = 0; return true;
    }
};

struct SrcPlain { const char* A; const char* B; unsigned lda2; int K;
    __device__ __forceinline__ void a_off(const Unit& u, const int (&R)[2], const int (&C)[2], unsigned (&o)[2][2]) const {
#pragma unroll
        for (int h = 0; h < 2; ++h)
#pragma unroll
            for (int i = 0; i < 2; ++i) o[h][i] = (unsigned)(u.pm * BM + h * HALF + R[i]) * lda2 + (unsigned)C[i] * 2u; }
    __device__ __forceinline__ const char* b_ptr(const Unit& u) const { return B + (size_t)u.pn * BM * K * 2; }
};
struct SrcSeg { const char* A; const char* B0; const char* B1; unsigned lda2; unsigned acol0, acol1; int K;
    __device__ __forceinline__ void a_off(const Unit& u, const int (&R)[2], const int (&C)[2], unsigned (&o)[2][2]) const {
        const unsigned cb = u.seg ? acol1 : acol0;
#pragma unroll
        for (int h = 0; h < 2; ++h)
#pragma unroll
            for (int i = 0; i < 2; ++i) o[h][i] = (unsigned)(u.pm * BM + h * HALF + R[i]) * lda2 + cb + (unsigned)C[i] * 2u; }
    __device__ __forceinline__ const char* b_ptr(const Unit& u) const { return (u.seg ? B1 : B0) + (size_t)u.pn * BM * K * 2; }
};
struct SrcMoe1 { const char* A; const char* B; const PG8_LAS int* tokL; int K;
    __device__ __forceinline__ void a_off(const Unit& u, const int (&R)[2], const int (&C)[2], unsigned (&o)[2][2]) const {
#pragma unroll
        for (int h = 0; h < 2; ++h)
#pragma unroll
            for (int i = 0; i < 2; ++i) { const int tk = tokL[(u.li < 15 ? u.li : 14) * 256 + h * HALF + R[i]]; o[h][i] = (unsigned)(tk >> 1) * 2048u + (unsigned)C[i] * 2u; } }
    __device__ __forceinline__ const char* b_ptr(const Unit& u) const { return B + ((size_t)u.e * 512 + (size_t)u.pn * BM) * 1024 * 2; }
};
struct SrcMoe2 { const char* A; const char* B; int K;
    __device__ __forceinline__ void a_off(const Unit& u, const int (&R)[2], const int (&C)[2], unsigned (&o)[2][2]) const {
#pragma unroll
        for (int h = 0; h < 2; ++h)
#pragma unroll
            for (int i = 0; i < 2; ++i) o[h][i] = (unsigned)(u.pm * BM + h * HALF + R[i]) * 512u + (unsigned)C[i] * 2u; }
    __device__ __forceinline__ const char* b_ptr(const Unit& u) const { return B + ((size_t)u.e * 1024 + (size_t)u.pn * BM) * 256 * 2; }
};

__device__ __forceinline__ unsigned cvt_pk_bf16(float lo, float hi) { unsigned r; asm volatile("v_cvt_pk_bf16_f32 %0, %1, %2" : "=v"(r) : "v"(lo), "v"(hi)); return r; }

template <class Epi, class Sched, class Src, bool ALIGN_EPI>
__device__ __forceinline__ void gemm_phase(PG8_LAS unsigned char* lds, const Src& src, const Sched& S, const Epi& E) {
    int tid_ = threadIdx.x; asm volatile("" : "+v"(tid_));
    const int tid = tid_, wid = __builtin_amdgcn_readfirstlane(tid >> 6), lane = tid & 63, wr = wid >> 2, wc = wid & 3, fr = lane & 15, fq = lane >> 4;
    const int K = src.K, nt = K / BK;
    int Rr[2], Cc[2]; unsigned voffB[2];
#pragma unroll
    for (int i = 0; i < 2; ++i) { int R, C; stage_rc(tid * 16 + i * 8192, R, C); const int Rb = Epi::PERM ? ((R & ~31) + perm32(R & 31)) : R; Rr[i] = R; Cc[i] = C; voffB[i] = (unsigned)(Rb * K + C) * 2u; }
    const unsigned kstep = (unsigned)(BK * 2);
    const size_t hstepB = (size_t)HALF * K * 2;
    const unsigned ldsw = (unsigned)wid * 1024u;
    const int aoff = lds_byte(wr * 64 + fr, fq * 8), boff = lds_byte(wc * 32 + fr, fq * 8);
    const char* const Ab = src.A;
#define PG8_SA(b, h) (((b) * 2 + (h)) * HTB)
#define PG8_SB(b, h) ((4 + (b) * 2 + (h)) * HTB)
#define PG8_STAGE_B(bufoff, gbase) do { _Pragma("unroll") for (int _i = 0; _i < 2; ++_i) \
        __builtin_amdgcn_global_load_lds((const unsigned*)((const char*)(gbase) + voffB[_i]), (PG8_LAS unsigned*)(lds + (bufoff) + ldsw + _i * 8192), 16, 0, 0); } while (0)
#define PG8_STAGE_A(bufoff, h, OFFS, kb) do { _Pragma("unroll") for (int _i = 0; _i < 2; ++_i) \
        __builtin_amdgcn_global_load_lds((const unsigned*)(Ab + (size_t)((OFFS)[h][_i] + (kb))), (PG8_LAS unsigned*)(lds + (bufoff) + ldsw + _i * 8192), 16, 0, 0); } while (0)
#define PG8_LDA(dst, b, h) do { _Pragma("unroll") for (int m = 0; m < 4; ++m) _Pragma("unroll") for (int k = 0; k < 2; ++k) dst[m][k] = *(const PG8_LAS bf16x8*)(lds + PG8_SA(b, h) + aoff + m * 2048 + k * 1024); } while (0)
#define PG8_LDB(dst, b, h) do { _Pragma("unroll") for (int n = 0; n < 2; ++n) _Pragma("unroll") for (int k = 0; k < 2; ++k) dst[n][k] = *(const PG8_LAS bf16x8*)(lds + PG8_SB(b, h) + boff + n * 2048 + k * 1024); } while (0)
#define PG8_MMA(ai, bj, At, Bt) do { __builtin_amdgcn_s_setprio(1); _Pragma("unroll") for (int m = 0; m < 4; ++m) _Pragma("unroll") for (int n = 0; n < 2; ++n) _Pragma("unroll") for (int k = 0; k < 2; ++k) \
        acc[ai][bj][m][n] = __builtin_amdgcn_mfma_f32_16x16x32_bf16(Bt[n][k], At[m][k], acc[ai][bj][m][n], 0, 0, 0); __builtin_amdgcn_s_setprio(0); } while (0)
#define PG8_WAIT_V(n) asm volatile("s_waitcnt vmcnt(" #n ")" ::: "memory")
#define PG8_WAIT_L(n) asm volatile("s_waitcnt lgkmcnt(" #n ")" ::: "memory")
#define PG8_BAR __builtin_amdgcn_s_barrier()
#define PG8_SCHED __builtin_amdgcn_sched_barrier(0)
    Unit cur, nxt; int ui = 0;
    if (!S.next(0, cur)) return;
    f32x4 acc[2][2][4][2];
#pragma unroll
    for (int a = 0; a < 2; ++a)
#pragma unroll
        for (int b = 0; b < 2; ++b)
#pragma unroll
            for (int m = 0; m < 4; ++m)
#pragma unroll
                for (int n = 0; n < 2; ++n) acc[a][b][m][n] = (f32x4){0.f, 0.f, 0.f, 0.f};
    bf16x8 At[4][2], B0[2][2], B1[2][2];
    unsigned ao[2][2], no[2][2];
    src.a_off(cur, Rr, Cc, ao);
    const char* cB = src.b_ptr(cur);
    PG8_STAGE_B(PG8_SB(0, 0), cB); PG8_STAGE_B(PG8_SB(0, 1), cB + hstepB); PG8_STAGE_A(PG8_SA(0, 0), 0, ao, 0u); PG8_STAGE_A(PG8_SA(0, 1), 1, ao, 0u);
    if (wr == 1) PG8_BAR;
    PG8_WAIT_V(2); PG8_BAR;
    PG8_STAGE_B(PG8_SB(1, 0), cB + kstep); PG8_STAGE_A(PG8_SA(1, 0), 0, ao, kstep); PG8_STAGE_B(PG8_SB(1, 1), cB + hstepB + kstep);
    PG8_WAIT_V(6); PG8_BAR;
    for (;;) {
        const bool has_next = S.next(ui + 1, nxt);
        const char* nB = cB;
        if (has_next) { src.a_off(nxt, Rr, Cc, no); nB = src.b_ptr(nxt); }
        else {
#pragma unroll
            for (int h = 0; h < 2; ++h)
#pragma unroll
                for (int i = 0; i < 2; ++i) no[h][i] = ao[h][i]; }
        for (int t = 0; t < nt; t += 2) {
            const bool last = (t == nt - 2);
            const unsigned k1 = (unsigned)(t + 1) * kstep;
            const unsigned k2 = last ? 0u : (unsigned)(t + 2) * kstep, k3 = k2 + kstep;
            unsigned a2[2][2];
#pragma unroll
            for (int h = 0; h < 2; ++h)
#pragma unroll
                for (int i = 0; i < 2; ++i) a2[h][i] = last ? no[h][i] : ao[h][i];
            const char* b2 = last ? nB : cB + (size_t)k2; const char* b3 = b2 + kstep;
            PG8_LDB(B0, 0, 0); PG8_LDB(B1, 0, 1); PG8_SCHED; PG8_LDA(At, 0, 0); PG8_STAGE_A(PG8_SA(1, 1), 1, ao, k1);
            PG8_WAIT_V(8); PG8_WAIT_L(0); PG8_BAR; PG8_MMA(0, 0, At, B0); PG8_MMA(0, 1, At, B1); PG8_BAR; PG8_SCHED;
            PG8_LDA(At, 0, 1); PG8_STAGE_B(PG8_SB(0, 0), b2); PG8_STAGE_B(PG8_SB(0, 1), b2 + hstepB); PG8_STAGE_A(PG8_SA(0, 0), 0, a2, k2);
            PG8_WAIT_V(8); PG8_WAIT_L(0); PG8_BAR; PG8_MMA(1, 0, At, B0); PG8_MMA(1, 1, At, B1); PG8_BAR; PG8_SCHED;
            PG8_LDB(B0, 1, 0); PG8_LDB(B1, 1, 1); PG8_SCHED; PG8_LDA(At, 1, 0); PG8_STAGE_A(PG8_SA(0, 1), 1, a2, k2);
            PG8_WAIT_V(8); PG8_WAIT_L(0); PG8_BAR; PG8_MMA(0, 0, At, B0); PG8_MMA(0, 1, At, B1); PG8_BAR; PG8_SCHED;
            PG8_LDA(At, 1, 1); PG8_STAGE_B(PG8_SB(1, 0), b3); PG8_STAGE_B(PG8_SB(1, 1), b3 + hstepB); PG8_STAGE_A(PG8_SA(1, 0), 0, a2, k3);
            PG8_WAIT_V(8); PG8_WAIT_L(0); PG8_BAR; PG8_MMA(1, 0, At, B0); PG8_MMA(1, 1, At, B1); PG8_BAR; PG8_SCHED;
        }
        if constexpr (ALIGN_EPI) { if (wr == 0) PG8_BAR; }
        int fr_ = fr, fq_ = fq; asm volatile("" : "+v"(fr_), "+v"(fq_));
        const bool keep = E(acc, cur, wr, wc, fr_, fq_);
        if (!has_next) break;
        if (!keep) {
#pragma unroll
            for (int a = 0; a < 2; ++a)
#pragma unroll
                for (int b = 0; b < 2; ++b)
#pragma unroll
                    for (int m = 0; m < 4; ++m)
#pragma unroll
                        for (int n = 0; n < 2; ++n) acc[a][b][m][n] = (f32x4){0.f, 0.f, 0.f, 0.f};
        }
        cur = nxt; cB = nB; ++ui;
#pragma unroll
        for (int h = 0; h < 2; ++h)
#pragma unroll
            for (int i = 0; i < 2; ++i) ao[h][i] = no[h][i];
        if constexpr (ALIGN_EPI) { if (wr == 1) PG8_BAR; }
    }
    PG8_WAIT_V(0);
    if constexpr (!ALIGN_EPI) { if (wr == 0) PG8_BAR; }
    PG8_BAR;
#undef PG8_SA
#undef PG8_SB
#undef PG8_STAGE_A
#undef PG8_STAGE_B
#undef PG8_LDA
#undef PG8_LDB
#undef PG8_MMA
#undef PG8_WAIT_V
#undef PG8_WAIT_L
#undef PG8_BAR
#undef PG8_SCHED
}

struct EpiProj {
    static constexpr bool PERM = true;
    bf16_t* P; bf16_t* R; bf16_t* GB; unsigned* NRM;
    __device__ __forceinline__ bool operator()(f32x4 (&acc)[2][2][4][2], const Unit& u, int wr, int wc, int fr, int fq) const {
        const int row0 = u.pm * BM + wr * 64 + fr;
        if (u.pn < 9) {
            const float sc = (u.pn < 2 || u.pn == 3 || u.pn == 4) ? C2 : 1.f;
            const int col0 = u.pn * BM + wc * 32 + 8 * fq;
            if (u.pn >= 3 && u.pn <= 6) {
                float mx[2] = {0.f, 0.f};
#pragma unroll
                for (int ai = 0; ai < 2; ++ai)
#pragma unroll
                    for (int m = 0; m < 4; ++m)
#pragma unroll
                        for (int bj = 0; bj < 2; ++bj) { const f32x4 a = acc[ai][bj][m][0] * sc, c = acc[ai][bj][m][1] * sc;
                            float ss = (a[0] * a[0] + a[1] * a[1]) + (a[2] * a[2] + a[3] * a[3]) + (c[0] * c[0] + c[1] * c[1]) + (c[2] * c[2] + c[3] * c[3]);
                            ss += __shfl_xor(ss, 16); ss += __shfl_xor(ss, 32); mx[bj] = fmaxf(mx[bj], ss); }
#pragma unroll
                for (int bj = 0; bj < 2; ++bj) { float m_ = mx[bj];
#pragma unroll
                    for (int o = 1; o < 16; o <<= 1) m_ = fmaxf(m_, __shfl_xor(m_, o));
                    if ((threadIdx.x & 63) == 0) { const int isk = (u.pn >= 5) ? 1 : 0, head = (u.pn - (isk ? 5 : 3)) * 4 + 2 * bj + (wc >> 1);
                        atomicMax(NRM + ((u.pm >> 4) * 8 + head) * 4 + isk * 2 + (wc & 1), __float_as_uint(m_)); } }
            }
#pragma unroll
            for (int ai = 0; ai < 2; ++ai)
#pragma unroll
                for (int m = 0; m < 4; ++m) { bf16_t* rowp = P + (size_t)(row0 + ai * HALF + m * 16) * PP + col0;
#pragma unroll
                    for (int bj = 0; bj < 2; ++bj) { const f32x4 v0 = acc[ai][bj][m][0] * sc, v1 = acc[ai][bj][m][1] * sc;
                        u32x4 w; w.x = cvt_pk_bf16(v0[0], v0[1]); w.y = cvt_pk_bf16(v0[2], v0[3]); w.z = cvt_pk_bf16(v1[0], v1[1]); w.w = cvt_pk_bf16(v1[2], v1[3]);
                        *(u32x4*)(rowp + bj * HALF) = w; } }
        } else {
            const int col0 = (u.pn - 9) * 128 + wc * 32 + 8 * fq;
#pragma unroll
            for (int ai = 0; ai < 2; ++ai)
#pragma unroll
                for (int m = 0; m < 4; ++m) { const size_t off = (size_t)(row0 + ai * HALF + m * 16) * 1024 + col0;
                    float r[8], g[8];
#pragma unroll
                    for (int n = 0; n < 2; ++n)
#pragma unroll
                        for (int j = 0; j < 4; ++j) { const float ea = fast_exp2(-acc[ai][0][m][n][j] * LOG2E), eb = fast_exp2(-acc[ai][1][m][n][j] * LOG2E);
                            const float gb = fast_rcp(1.f + eb); g[n * 4 + j] = gb; r[n * 4 + j] = (1.f + eb) * fast_rcp(1.f + ea); }
                    u32x4 wr_, wg_;
                    wr_.x = cvt_pk_bf16(r[0], r[1]); wr_.y = cvt_pk_bf16(r[2], r[3]); wr_.z = cvt_pk_bf16(r[4], r[5]); wr_.w = cvt_pk_bf16(r[6], r[7]);
                    wg_.x = cvt_pk_bf16(g[0], g[1]); wg_.y = cvt_pk_bf16(g[2], g[3]); wg_.z = cvt_pk_bf16(g[4], g[5]); wg_.w = cvt_pk_bf16(g[6], g[7]);
                    *(u32x4*)(R + off) = wr_; *(u32x4*)(GB + off) = wg_; }
        }
        return false;
    }
};
struct EpiMerge {
    static constexpr bool PERM = true;
    const bf16_t* R; const bf16_t* GB; bf16_t* MG;
    __device__ __forceinline__ bool operator()(f32x4 (&acc)[2][2][4][2], const Unit& u, int wr, int wc, int fr, int fq) const {
        const int row0 = u.pm * BM + wr * 64 + fr, col0 = u.pn * BM + wc * 32 + 8 * fq;
        const bf16_t* S = u.seg ? GB : R;
        u32x4 sv[2][4][2];
#pragma unroll
        for (int ai = 0; ai < 2; ++ai)
#pragma unroll
            for (int m = 0; m < 4; ++m)
#pragma unroll
                for (int bj = 0; bj < 2; ++bj) sv[ai][m][bj] = *(const u32x4*)(S + (size_t)(row0 + ai * HALF + m * 16) * 1024 + col0 + bj * HALF);
#pragma unroll
        for (int ai = 0; ai < 2; ++ai)
#pragma unroll
            for (int m = 0; m < 4; ++m) { const size_t off = (size_t)(row0 + ai * HALF + m * 16) * MGP + col0;
#pragma unroll
                for (int bj = 0; bj < 2; ++bj) { const u32x4 s = sv[ai][m][bj];
                    f32x4 f0 = {bflo(s.x), bfhi(s.x), bflo(s.y), bfhi(s.y)}, f1 = {bflo(s.z), bfhi(s.z), bflo(s.w), bfhi(s.w)};
                    acc[ai][bj][m][0] = acc[ai][bj][m][0] * f0; acc[ai][bj][m][1] = acc[ai][bj][m][1] * f1;
                    if (u.seg) { const f32x4 v0 = acc[ai][bj][m][0], v1 = acc[ai][bj][m][1]; u32x4 w; w.x = cvt_pk_bf16(v0[0], v0[1]); w.y = cvt_pk_bf16(v0[2], v0[3]); w.z = cvt_pk_bf16(v1[0], v1[1]); w.w = cvt_pk_bf16(v1[2], v1[3]);
                        *(u32x4*)(MG + off + bj * HALF) = w; } } }
        return u.seg == 0;
    }
};
struct EpiResid {
    static constexpr bool PERM = true;
    const float* X; const float* MOD; bf16_t* X1;
    __device__ __forceinline__ bool operator()(f32x4 (&acc)[2][2][4][2], const Unit& u, int wr, int wc, int fr, int fq) const {
        const int row0 = u.pm * BM + wr * 64 + fr, col0 = u.pn * BM + wc * 32 + 8 * fq;
        const float* gm = MOD + (size_t)(u.pm >> 4) * 6144 + 2048 + col0;
        f32x4 g4[2][2];
#pragma unroll
        for (int bj = 0; bj < 2; ++bj)
#pragma unroll
            for (int n = 0; n < 2; ++n) g4[bj][n] = *(const f32x4*)(gm + bj * HALF + n * 4);
#pragma unroll
        for (int ai = 0; ai < 2; ++ai)
#pragma unroll
            for (int m = 0; m < 4; ++m) { const size_t off = (size_t)(row0 + ai * HALF + m * 16) * 1024 + col0;
#pragma unroll
                for (int bj = 0; bj < 2; ++bj) { const f32x4 x0 = *(const f32x4*)(X + off + bj * HALF), x1v = *(const f32x4*)(X + off + bj * HALF + 4);
                    const f32x4 v0 = x0 + g4[bj][0] * acc[ai][bj][m][0], v1 = x1v + g4[bj][1] * acc[ai][bj][m][1];
                    u32x4 w; w.x = cvt_pk_bf16(v0[0], v0[1]); w.y = cvt_pk_bf16(v0[2], v0[3]); w.z = cvt_pk_bf16(v1[0], v1[1]); w.w = cvt_pk_bf16(v1[2], v1[3]);
                    *(u32x4*)(X1 + off + bj * HALF) = w; } }
        return false;
    }
};
struct EpiHid {
    static constexpr bool PERM = true;
    const float* WL; const PG8_LAS int* cnt; bf16_t* HID;
    __device__ __forceinline__ bool operator()(f32x4 (&acc)[2][2][4][2], const Unit& u, int wr, int wc, int fr, int fq) const {
        const int n_e = cnt[u.e]; const int col0 = u.pn * 128 + wc * 32 + 8 * fq;
        float wv[2][4];
#pragma unroll
        for (int ai = 0; ai < 2; ++ai)
#pragma unroll
            for (int m = 0; m < 4; ++m) { const int slot = u.seg * 256 + ai * HALF + wr * 64 + m * 16 + fr; wv[ai][m] = (slot < n_e) ? WL[(size_t)u.e * LCAP + slot] : 0.f; }
#pragma unroll
        for (int ai = 0; ai < 2; ++ai)
#pragma unroll
            for (int m = 0; m < 4; ++m) { const int rl = ai * HALF + wr * 64 + m * 16 + fr; const int slot = u.seg * 256 + rl;
                if (slot < n_e) { const float w = wv[ai][m]; float h[8];
#pragma unroll
                    for (int n = 0; n < 2; ++n)
#pragma unroll
                        for (int j = 0; j < 4; ++j) { const float g = acc[ai][0][m][n][j], up = acc[ai][1][m][n][j]; h[n * 4 + j] = g * fast_rcp(1.f + fast_exp2(-g * LOG2E)) * up * w; }
                    u32x4 o; o.x = cvt_pk_bf16(h[0], h[1]); o.y = cvt_pk_bf16(h[2], h[3]); o.z = cvt_pk_bf16(h[4], h[5]); o.w = cvt_pk_bf16(h[6], h[7]);
                    *(u32x4*)(HID + ((size_t)u.pm * 256 + rl) * 256 + col0) = o; } }
        return false;
    }
};
struct EpiY {
    static constexpr bool PERM = true;
    const int* TOKL; const PG8_LAS int* cnt; bf16_t* Y2;
    __device__ __forceinline__ bool operator()(f32x4 (&acc)[2][2][4][2], const Unit& u, int wr, int wc, int fr, int fq) const {
        const int n_e = cnt[u.e]; const int col0 = u.pn * BM + wc * 32 + 8 * fq;
        int tkv[2][4];
#pragma unroll
        for (int ai = 0; ai < 2; ++ai)
#pragma unroll
            for (int m = 0; m < 4; ++m) { const int slot = u.seg * 256 + ai * HALF + wr * 64 + m * 16 + fr; tkv[ai][m] = (slot < n_e) ? TOKL[(size_t)u.e * LCAP + slot] : 0; }
#pragma unroll
        for (int ai = 0; ai < 2; ++ai)
#pragma unroll
            for (int m = 0; m < 4; ++m) { const int rl = ai * HALF + wr * 64 + m * 16 + fr; const int slot = u.seg * 256 + rl;
                if (slot < n_e) { const int tk = tkv[ai][m]; bf16_t* rowp = Y2 + (size_t)tk * 1024 + col0;
#pragma unroll
                    for (int bj = 0; bj < 2; ++bj) { const f32x4 v0 = acc[ai][bj][m][0], v1 = acc[ai][bj][m][1]; u32x4 w; w.x = cvt_pk_bf16(v0[0], v0[1]); w.y = cvt_pk_bf16(v0[2], v0[3]); w.z = cvt_pk_bf16(v1[0], v1[1]); w.w = cvt_pk_bf16(v1[2], v1[3]);
                        *(u32x4*)(rowp + bj * HALF) = w; } } }
        return false;
    }
};

}

namespace attn_body {
using bf16 = __hip_bfloat16;
using bf16x8 = __attribute__((ext_vector_type(8))) short;
using s16x4 = __attribute__((ext_vector_type(4))) short;
using f32x16 = __attribute__((ext_vector_type(16))) float;
using u32x4 = __attribute__((ext_vector_type(4))) unsigned;
constexpr int DH = 64, DM = PP;
constexpr int NW = 8, QBLK = 32, QB = QBLK * NW, KVBLK = 64;
__device__ __forceinline__ int crow(int r, int hi) { return (r & 3) + 8 * (r >> 2) + 4 * hi; }
#define SBAR() __builtin_amdgcn_sched_barrier(0)
__device__ __forceinline__ void cmask(f32x16& p0, f32x16& p1, int jb, int qrel, int hi) {
    const float NEG = -INFINITY; int kb = 64 * jb + 4 * hi;
#pragma unroll
    for (int r = 0; r < 16; ++r) { int kv = kb + (r & 3) + 8 * (r >> 2); if (kv > qrel) p0[r] = NEG; if (kv + 32 > qrel) p1[r] = NEG; }
}
constexpr int NSLOT = 3, SLOTB = 8192;
constexpr int LDS_K = 0, LDS_V = NSLOT * SLOTB, LDS_WS = 2 * NSLOT * SLOTB, LDS_TBL = LDS_WS + NW * 64 * 4  , LDS_OST = LDS_TBL + 8192, LDS_ATT = LDS_OST + NW * 4096;
constexpr int LDS_CUM = 94208;
constexpr int LDS_BYTES_ATT = LDS_CUM + 16384;
__device__ __forceinline__ void glds16(const void* gsrc, unsigned lds_dst) { unsigned keep;
    asm volatile("s_mov_b32 %0, m0\n\ts_mov_b32 m0, %2\n\ts_nop 0\n\tglobal_load_lds_dwordx4 %1, off\n\ts_mov_b32 m0, %0" : "=&s"(keep) : "v"(gsrc), "s"(lds_dst) : "memory"); }
__device__ __forceinline__ float max3f(float a, float b, float c) { float r; asm("v_max3_f32 %0, %1, %2, %3" : "=v"(r) : "v"(a), "v"(b), "v"(c)); return r; }
__device__ __forceinline__ float max2f(float a, float b) { float r; asm("v_max_f32_e32 %0, %1, %2" : "=v"(r) : "v"(a), "v"(b)); return r; }
__device__ __forceinline__ float fadd_s(float a, float b) { float r; asm("v_add_f32_e32 %0, %1, %2" : "=v"(r) : "v"(a), "v"(b)); return r; }
__device__ __forceinline__ float fsub_s(float a, float b) { float r; asm("v_sub_f32_e32 %0, %1, %2" : "=v"(r) : "v"(a), "v"(b)); return r; }
typedef float f32x2_t __attribute__((ext_vector_type(2))); typedef __bf16 bf16x2_t __attribute__((ext_vector_type(2)));
__device__ __forceinline__ unsigned cvtpk_s(float lo, float hi) { f32x2_t v = {lo, hi}; bf16x2_t b = __builtin_convertvector(v, bf16x2_t); return __builtin_bit_cast(unsigned, b); }
#define WAIT_BAR(N) asm volatile("s_waitcnt vmcnt(" #N ") lgkmcnt(0)\n\ts_barrier" ::: "memory")

typedef __attribute__((address_space(3))) const char* lds_cptr;
typedef __attribute__((address_space(3))) const float* lds_fptr;
typedef short v4i16_t __attribute__((ext_vector_type(4)));
typedef float f32x4_t __attribute__((ext_vector_type(4)));
__device__ __forceinline__ void kload8(bf16x8* kf, lds_cptr kp) {
    kf[0] = *(const __attribute__((address_space(3))) bf16x8*)(kp);        kf[1] = *(const __attribute__((address_space(3))) bf16x8*)(kp + 512);
    kf[2] = *(const __attribute__((address_space(3))) bf16x8*)(kp + 2048); kf[3] = *(const __attribute__((address_space(3))) bf16x8*)(kp + 2560);
    kf[4] = *(const __attribute__((address_space(3))) bf16x8*)(kp + 4096); kf[5] = *(const __attribute__((address_space(3))) bf16x8*)(kp + 4608);
    kf[6] = *(const __attribute__((address_space(3))) bf16x8*)(kp + 6144); kf[7] = *(const __attribute__((address_space(3))) bf16x8*)(kp + 6656);
}
__device__ __forceinline__ void kload2(bf16x8* kf, lds_cptr kp, int j) { kf[2 * j] = *(const __attribute__((address_space(3))) bf16x8*)(kp + j * 2048); kf[2 * j + 1] = *(const __attribute__((address_space(3))) bf16x8*)(kp + j * 2048 + 512); }
__device__ __forceinline__ s16x4 vtr(lds_cptr p) { return __builtin_bit_cast(s16x4, __builtin_amdgcn_ds_read_tr16_b64_v4i16((__attribute__((address_space(3))) v4i16_t*)p)); }
__device__ __forceinline__ float rowmax(const f32x16& p0, const f32x16& p1) {
    float a = max3f(p0[0], p0[1], p1[0]), b = max3f(p0[2], p0[3], p1[1]); a = max3f(a, p1[2], p1[3]);
#pragma unroll
    for (int r = 4; r < 16; r += 4) { a = max3f(a, p0[r], p0[r + 1]); b = max3f(b, p0[r + 2], p0[r + 3]); a = max3f(a, p1[r], p1[r + 1]); b = max3f(b, p1[r + 2], p1[r + 3]); }
    const float m = max2f(a, b);
    auto rr = __builtin_amdgcn_permlane32_swap(__float_as_uint(m), __float_as_uint(m), false, false);
    return max2f(__uint_as_float(rr[0]), __uint_as_float(rr[1]));
}
__device__ __forceinline__ void pv(f32x16* o, int vb, bf16x8 pa0, bf16x8 pa1, bf16x8 pa2, bf16x8 pa3) {
#pragma unroll
    for (int d0 = 0; d0 < 2; ++d0) { s16x4 lo[4], hi[4];
#pragma unroll
        for (int ks = 0; ks < 4; ++ks) {
            asm volatile("ds_read_b64_tr_b16 %0,%1 offset:%c2" : "=&v"(lo[ks]) : "v"(vb), "i"(d0 * 4096 + ks * 1024) : "memory");
            asm volatile("ds_read_b64_tr_b16 %0,%1 offset:%c2" : "=&v"(hi[ks]) : "v"(vb), "i"(d0 * 4096 + ks * 1024 + 512) : "memory"); }
        asm volatile("s_waitcnt lgkmcnt(0)" ::: "memory"); SBAR();
#define PK(k) (bf16x8){lo[k][0], lo[k][1], lo[k][2], lo[k][3], hi[k][0], hi[k][1], hi[k][2], hi[k][3]}
        o[d0] = __builtin_amdgcn_mfma_f32_32x32x16_bf16(pa0, PK(0), o[d0], 0, 0, 0);
        o[d0] = __builtin_amdgcn_mfma_f32_32x32x16_bf16(pa1, PK(1), o[d0], 0, 0, 0);
        o[d0] = __builtin_amdgcn_mfma_f32_32x32x16_bf16(pa2, PK(2), o[d0], 0, 0, 0);
        o[d0] = __builtin_amdgcn_mfma_f32_32x32x16_bf16(pa3, PK(3), o[d0], 0, 0, 0);
#undef PK
    }
}

#define ATTN_STORE16(p, v) (*(u32x4*)(p) = (v))
template <int MODE, int THRL> __device__ __forceinline__ void attn_unit(int b, int hq, int qb, bf16* P, const float* __restrict__ aux, float sink2, char* shm, bool do_store, float thr, unsigned* qhead, volatile __attribute__((address_space(3))) int* qslot) {
    int tid_ = threadIdx.x; asm volatile("" : "+v"(tid_));
    const int tid = tid_, lane = tid & 63, r32 = lane & 31, hi = lane >> 5; const int wid = __builtin_amdgcn_readfirstlane(tid >> 6);
    const int hw = (MODE == 1) ? hq + (wid >> 2) : hq, wrow = (MODE == 1) ? (wid & 3) * QBLK : wid * QBLK;
    const long rowbase = (long)b * SEQ; const int q0 = (MODE == 1) ? qb * 128 : qb * QB;
    int k0;
    if (MODE == 1) k0 = (q0 >= 128 ? q0 - 128 : 0);
    else {
        const float* cg = aux + (long)(b * 8 + hq) * SEQ; const int NT0 = (q0 + QB) / KVBLK;
        const float cq0 = cg[q0]; const float ckT = (lane < NT0) ? cg[64 * lane + 63] : 0.f;
        const unsigned long long keep = __ballot((lane < NT0) && (cq0 - ckT > thr));
        int tf = keep ? (int)__builtin_ctzll(keep) : NT0; tf &= ~1; if (tf > NT0 - 4) tf = NT0 - 4;
        k0 = 64 * __builtin_amdgcn_readfirstlane(tf);
    }
    const int qcol = (MODE == 1) ? C_QA + hw * 64 : C_QB + hq * 64;
    const int kcol = (MODE == 1) ? C_KA + (hq >> 2) * 64 : C_KB + hq * 64;
    const int vcol = (MODE == 1) ? C_VA + (hq >> 2) * 64 : C_VB + hq * 64;
    const bf16* Qw = P + (rowbase + q0 + wrow) * DM + qcol;
    const bf16* Kh = P + (rowbase + k0) * DM + kcol, *Vh = P + (rowbase + k0) * DM + vcol;
    const unsigned lds0 = (unsigned)(uintptr_t)shm;
    float* wsf = (float*)(shm + LDS_WS) + wid * 64;
    const lds_cptr shm3 = (lds_cptr)shm;
    const lds_fptr cumL = (lds_fptr)(shm3 + (MODE == 0 ? LDS_CUM : LDS_TBL + (wid >> 2) * 4096));
    if (MODE == 0) { const float* src = aux + (long)(b * 8 + hq) * SEQ; for (int i = tid * 4; i < q0 + QB; i += 2048) *(f32x4_t*)((float*)(shm + LDS_CUM) + i) = *(const f32x4_t*)(src + i); }
    else { const float* src = aux + hq * 1024;
#pragma unroll
        for (int i = 0; i < 4; ++i) ((float*)(shm + LDS_TBL))[tid + 512 * i] = src[tid + 512 * i]; }
    const bf16* ksrc = Kh + (long)lane * DM + wid * 8;
    const bf16* vsrc = Vh + (long)(16 * (wid & 3) + (lane >> 2)) * DM + (wid >> 2) * 32 + (lane & 3) * 8;
    const unsigned kdst = lds0 + LDS_K + wid * 1024, vdst = lds0 + LDS_V + wid * 1024;
#define DMA_K(t, slot) glds16(ksrc + (long)(t) * KVBLK * DM, (unsigned)__builtin_amdgcn_readfirstlane(kdst + (slot)))
#define DMA_V(t, slot) glds16(vsrc + (long)(t) * KVBLK * DM, (unsigned)__builtin_amdgcn_readfirstlane(vdst + (slot)))
    const int vb0 = (int)(lds0 + LDS_V) + ((lane >> 4) & 1) * 32 + (lane & 3) * 8 + (4 * hi + ((lane & 15) >> 2)) * 64;
    bf16x8 kf[8];
    const lds_cptr kp0 = shm3 + LDS_K + hi * 1024 + r32 * 16; const lds_cptr vp0 = shm3 + LDS_V + ((lane >> 4) & 1) * 32 + (lane & 3) * 8 + (4 * hi + ((lane & 15) >> 2)) * 64;
    const int NT = (MODE == 1) ? 4 : (q0 + QB - k0) / KVBLK;
    DMA_K(0, 0); DMA_V(0, 0); DMA_K(1, SLOTB);
    bf16x8 qr[4];
#pragma unroll
    for (int d0 = 0; d0 < 4; ++d0) qr[d0] = *reinterpret_cast<const bf16x8*>(&Qw[(long)r32 * DM + d0 * 16 + hi * 8]);
    float mhat = 0.f, negq = 0.f, l_reg = 0.f; f32x16 o[2]; o[0] = f32x16{}; o[1] = f32x16{};
    const int qrel = wrow + r32;
    const int qk0 = q0 + qrel - k0;
#define CINIT(C0, C1, t) do { if (MODE == 0) { const lds_fptr ck_ = cumL + (k0 + 64 * (t) + 4 * hi); \
        _Pragma("unroll") for (int j_ = 0; j_ < 4; ++j_) { const f32x4_t a_ = *(const __attribute__((address_space(3))) f32x4_t*)(ck_ + 8 * j_), b_ = *(const __attribute__((address_space(3))) f32x4_t*)(ck_ + 32 + 8 * j_); \
            _Pragma("unroll") for (int i_ = 0; i_ < 4; ++i_) { C0[4 * j_ + i_] = negq - a_[i_]; C1[4 * j_ + i_] = negq - b_[i_]; } } } \
      else { const lds_fptr tb_ = cumL + (qk0 - 64 * (t) - 4 * hi + 256); \
        _Pragma("unroll") for (int r_ = 0; r_ < 16; ++r_) { const int kv_ = (r_ & 3) + 8 * (r_ >> 2); C0[r_] = negq + tb_[-kv_]; C1[r_] = negq + tb_[-kv_ - 32]; } } } while (0)
#define CMASK(P0, P1, t) do { if (MODE == 0) { int jb_ = (t) - (NT - 4); if (jb_ >= 0) cmask(P0, P1, jb_, qrel, hi); } \
      } while (0)
    bool resc = false;
#define START(P0, P1) do { const float rm = rowmax(P0, P1); resc = false; \
    { const float dl = (rm < -1e30f) ? 0.f : rm; mhat = fadd_s(mhat, dl); negq = fsub_s(negq, dl); \
      _Pragma("unroll") for (int r = 0; r < 16; ++r) { P0[r] = fsub_s(P0[r], dl); P1[r] = fsub_s(P1[r], dl); } } \
    _Pragma("unroll") for (int r = 0; r < 16; ++r) P0[r] = __builtin_amdgcn_exp2f(P0[r]); } while (0)
#define RESC() do { if (resc) { asm volatile("s_waitcnt lgkmcnt(0)" ::: "memory"); \
      _Pragma("unroll") for (int d_ = 0; d_ < 2; ++d_) _Pragma("unroll") for (int r = 0; r < 16; ++r) o[d_][r] *= wsf[crow(r, hi)]; } } while (0)
    f32x16 pA0, pA1, pB0, pB1;
    int sl_prev = 0, sl_cur = 0, sl_next = SLOTB;
#define ROT() do { sl_prev = sl_cur; sl_cur = sl_next; sl_next = (sl_next == (NSLOT - 1) * SLOTB) ? 0 : sl_next + SLOTB; } while (0)
    DMA_K(2, 2 * SLOTB);
    WAIT_BAR(3);
    if (MODE == 0) negq = cumL[q0 + qrel];
    { CINIT(pA0, pA1, 0);
      const char* kb = shm + LDS_K + hi * 1024 + r32 * 16;
#pragma unroll
      for (int d0 = 0; d0 < 4; ++d0) {
          const bf16x8 b0 = *reinterpret_cast<const bf16x8*>(kb + d0 * 2048);
          const bf16x8 b1 = *reinterpret_cast<const bf16x8*>(kb + d0 * 2048 + 512);
          pA0 = __builtin_amdgcn_mfma_f32_32x32x16_bf16(b0, qr[d0], pA0, 0, 0, 0); pA1 = __builtin_amdgcn_mfma_f32_32x32x16_bf16(b1, qr[d0], pA1, 0, 0, 0); } }
    asm volatile("s_nop 15\n\ts_nop 7" : "+v"(pA0), "+v"(pA1)); CMASK(pA0, pA1, 0);
    asm volatile("s_nop 7" : "+v"(pA0), "+v"(pA1));
    START(pA0, pA1);
#pragma unroll
    for (int r = 0; r < 16; ++r) pA1[r] = __builtin_amdgcn_exp2f(pA1[r]);
    WAIT_BAR(0);
    DMA_K(3, 0); DMA_V(1, SLOTB);
    ROT();
    kload8(kf, kp0 + sl_cur);
    WAIT_BAR(2);
    s16x4 vlo[8], vhi[8]; u32x4 pw0, pw1, pw2, pw3;
#define PKW(P, B) cvtpk_s(P[B], P[B + 1])
#define PAF(k) __builtin_bit_cast(bf16x8, pw##k)
#define VFR(i) (bf16x8){vlo[i][0], vlo[i][1], vlo[i][2], vlo[i][3], vhi[i][0], vhi[i][1], vhi[i][2], vhi[i][3]}
#define PIN(x) asm volatile("" : "+v"(x))
#define MX3(a, b, c) __builtin_fmaxf(__builtin_fmaxf((a), (b)), (c))
#define GAPA(MF, A0, A1, A2, A3, W0, W1, PW) do { MF; sacc += A0; sacc += A1; sacc += A2; sacc += A3; PIN(sacc); W0; W1; PIN(PW); SBAR(); } while (0)
#define EX(v) __builtin_amdgcn_exp2f(v)
#define GAPB(MF, X, B) do { MF; X[B] = EX(X[B]); X[B + 1] = EX(X[B + 1]); X[B + 2] = EX(X[B + 2]); X[B + 3] = EX(X[B + 3]); PIN(X); SBAR(); } while (0)
#define VRD(i) do { vlo[i] = vtr(vp_ + (((i) >> 2) * 4096 + ((i) & 3) * 1024)); vhi[i] = vtr(vp_ + (((i) >> 2) * 4096 + ((i) & 3) * 1024 + 512)); } while (0)
#define KRD(G, j) do { if (G) { kload2(kf, kp0 + sl_next, j); SBAR(); } } while (0)
#define STEP(C0, C1, P0, P1, t, GK, GV, GL) do { SBAR(); \
    const lds_cptr vp_ = vp0 + sl_prev; \
    CINIT(C0, C1, t); SBAR(); \
    VRD(0); SBAR(); float sacc = (P0[0] + P0[1]); \
    GAPA(C0 = __builtin_amdgcn_mfma_f32_32x32x16_bf16(kf[0], qr[0], C0, 0, 0, 0), P0[2], P0[3], P0[4], P0[5],     pw0[0] = PKW(P0, 0), pw0[1] = PKW(P0, 2), pw0); \
    VRD(4); SBAR(); GAPA(C1 = __builtin_amdgcn_mfma_f32_32x32x16_bf16(kf[1], qr[0], C1, 0, 0, 0), P0[6], P0[7], P0[8], P0[9],     pw0[2] = PKW(P0, 4), pw0[3] = PKW(P0, 6), pw0); \
    VRD(1); SBAR(); GAPA(C0 = __builtin_amdgcn_mfma_f32_32x32x16_bf16(kf[2], qr[1], C0, 0, 0, 0),   P0[10], P0[11], P0[12], P0[13], pw1[0] = PKW(P0, 8), pw1[1] = PKW(P0, 10), pw1); \
    VRD(5); SBAR(); GAPA(C1 = __builtin_amdgcn_mfma_f32_32x32x16_bf16(kf[3], qr[1], C1, 0, 0, 0),   P0[14], P0[15], P1[0], P1[1],   pw1[2] = PKW(P0, 12), pw1[3] = PKW(P0, 14), pw1); \
    VRD(2); SBAR(); GAPA(C0 = __builtin_amdgcn_mfma_f32_32x32x16_bf16(kf[4], qr[2], C0, 0, 0, 0),   P1[2], P1[3], P1[4], P1[5],     pw2[0] = PKW(P1, 0), pw2[1] = PKW(P1, 2), pw2); \
    VRD(6); SBAR(); GAPA(C1 = __builtin_amdgcn_mfma_f32_32x32x16_bf16(kf[5], qr[2], C1, 0, 0, 0),   P1[6], P1[7], P1[8], P1[9],     pw2[2] = PKW(P1, 4), pw2[3] = PKW(P1, 6), pw2); \
    VRD(3); SBAR(); GAPA(C0 = __builtin_amdgcn_mfma_f32_32x32x16_bf16(kf[6], qr[3], C0, 0, 0, 0),   P1[10], P1[11], P1[12], P1[13], pw3[0] = PKW(P1, 8), pw3[1] = PKW(P1, 10), pw3); \
    VRD(7); SBAR(); GAPA(C1 = __builtin_amdgcn_mfma_f32_32x32x16_bf16(kf[7], qr[3], C1, 0, 0, 0),   P1[14], P1[15], 0.f, 0.f,       pw3[2] = PKW(P1, 12), pw3[3] = PKW(P1, 14), pw3); \
    l_reg += sacc; \
    if (GK) { DMA_K((t) + 3, sl_cur); } if (GV) { DMA_V((t) + 1, sl_next); } \
    CMASK(C0, C1, t); \
    { float a = MX3(C0[0], C0[1], C1[0]), b = MX3(C0[2], C0[3], C1[1]); a = MX3(a, C1[2], C1[3]); \
      _Pragma("unroll") for (int r = 4; r < 16; r += 4) { a = MX3(a, C0[r], C0[r + 1]); b = MX3(b, C0[r + 2], C0[r + 3]); a = MX3(a, C1[r], C1[r + 1]); b = MX3(b, C1[r + 2], C1[r + 3]); } \
      float rm = __builtin_fmaxf(a, b); { auto rr = __builtin_amdgcn_permlane32_swap(__float_as_uint(rm), __float_as_uint(rm), false, false); rm = __builtin_fmaxf(__uint_as_float(rr[0]), __uint_as_float(rr[1])); } \
      resc = false; \
      if (__builtin_expect(__any(rm > (float)THRL), 0)) { const float dl = __builtin_fmaxf(rm, 0.f); mhat += dl; negq -= dl; \
        _Pragma("unroll") for (int r = 0; r < 16; ++r) { C0[r] -= dl; C1[r] -= dl; } \
        const float f = __builtin_amdgcn_exp2f(-dl); l_reg *= f; if (hi == 0) wsf[r32] = f; resc = true; } } \
    SBAR(); \
    GAPB(o[0] = __builtin_amdgcn_mfma_f32_32x32x16_bf16(PAF(0), VFR(0), o[0], 0, 0, 0), C0, 0); \
    GAPB(o[1] = __builtin_amdgcn_mfma_f32_32x32x16_bf16(PAF(0), VFR(4), o[1], 0, 0, 0), C0, 4); \
    KRD(GL, 0); GAPB(o[0] = __builtin_amdgcn_mfma_f32_32x32x16_bf16(PAF(1), VFR(1), o[0], 0, 0, 0), C0, 8); \
    KRD(GL, 1); GAPB(o[1] = __builtin_amdgcn_mfma_f32_32x32x16_bf16(PAF(1), VFR(5), o[1], 0, 0, 0), C0, 12); \
    KRD(GL, 2); GAPB(o[0] = __builtin_amdgcn_mfma_f32_32x32x16_bf16(PAF(2), VFR(2), o[0], 0, 0, 0), C1, 0); \
    KRD(GL, 3); GAPB(o[1] = __builtin_amdgcn_mfma_f32_32x32x16_bf16(PAF(2), VFR(6), o[1], 0, 0, 0), C1, 4); \
    GAPB(o[0] = __builtin_amdgcn_mfma_f32_32x32x16_bf16(PAF(3), VFR(3), o[0], 0, 0, 0), C1, 8); \
    GAPB(o[1] = __builtin_amdgcn_mfma_f32_32x32x16_bf16(PAF(3), VFR(7), o[1], 0, 0, 0), C1, 12); \
    } while (0)
    int t = 1;
    if (MODE == 0) {
        for (; t + 5 < NT; t += 2) {
            STEP(pB0, pB1, pA0, pA1, t, true, true, true);     WAIT_BAR(2); RESC(); ROT();
            STEP(pA0, pA1, pB0, pB1, t + 1, true, true, true); WAIT_BAR(2); RESC(); ROT();
        }
    }
#define ENDW(tt) do { if ((tt) + 3 < NT) { WAIT_BAR(2); } else if ((tt) + 2 < NT) { WAIT_BAR(1); } else { WAIT_BAR(0); } } while (0)
    for (; t + 1 < NT; t += 2) {
        STEP(pB0, pB1, pA0, pA1, t, (t + 3 < NT), (t + 1 < NT), (t + 1 < NT));         ENDW(t);     RESC(); ROT();
        STEP(pA0, pA1, pB0, pB1, t + 1, (t + 4 < NT), (t + 2 < NT), (t + 2 < NT));     ENDW(t + 1); RESC(); ROT();
    }
    STEP(pB0, pB1, pA0, pA1, NT - 1, false, false, false); RESC();
    { float sacc = pB0[0] + pB0[1];
#pragma unroll
      for (int r = 2; r < 16; ++r) sacc += pB0[r];
#pragma unroll
      for (int r = 0; r < 16; ++r) sacc += pB1[r];
      l_reg += sacc;
      pw0 = (u32x4){PKW(pB0, 0), PKW(pB0, 2), PKW(pB0, 4), PKW(pB0, 6)}; pw1 = (u32x4){PKW(pB0, 8), PKW(pB0, 10), PKW(pB0, 12), PKW(pB0, 14)}; pw2 = (u32x4){PKW(pB1, 0), PKW(pB1, 2), PKW(pB1, 4), PKW(pB1, 6)}; pw3 = (u32x4){PKW(pB1, 8), PKW(pB1, 10), PKW(pB1, 12), PKW(pB1, 14)};
      SBAR(); pv(o, vb0 + sl_cur, PAF(0), PAF(1), PAF(2), PAF(3)); }
#undef PKW
#undef PAF
#undef VFR
#undef PIN
#undef MX3
#undef GAPA
#undef GAPB
#undef EX
#undef VRD
#undef KRD
#undef STEP
#undef ENDW
    int nxt_ = 0; if (tid == 0) nxt_ = (int)__hip_atomic_fetch_add(qhead, 1u, __ATOMIC_RELAXED, __HIP_MEMORY_SCOPE_AGENT);
    { auto rr = __builtin_amdgcn_permlane32_swap(__float_as_uint(l_reg), __float_as_uint(l_reg), false, false); l_reg = __uint_as_float(rr[0]) + __uint_as_float(rr[1]); }
    if (MODE == 1) l_reg += __builtin_amdgcn_exp2f(aux[8192 + hw] - mhat);
    if (hi == 0) wsf[32 + r32] = l_reg; asm volatile("s_waitcnt lgkmcnt(0)" ::: "memory");
    float rli[16];
#pragma unroll
    for (int r = 0; r < 16; ++r) rli[r] = __builtin_amdgcn_rcpf(wsf[32 + crow(r, hi)]);
    bf16* Ow = P + (rowbase + q0 + wrow) * DM + qcol;
    { bf16* stg = (bf16*)(shm + LDS_OST) + wid * 2048;
#pragma unroll
      for (int r = 0; r < 16; ++r) { const int orow = crow(r, hi);
#pragma unroll
          for (int d0 = 0; d0 < 2; ++d0) stg[orow * 64 + d0 * 32 + r32] = __float2bfloat16(o[d0][r] * rli[r]); }
      asm volatile("s_waitcnt lgkmcnt(0)" ::: "memory");
#pragma unroll
      for (int i = 0; i < 4; ++i) { const int row = i * 8 + (lane >> 3), ch = lane & 7; const u32x4 v = *(const u32x4*)(stg + row * 64 + ch * 8); if (do_store) ATTN_STORE16(Ow + (long)row * DM + ch * 8, v); } }
    if (tid == 0) qslot[0] = nxt_;
    asm volatile("s_waitcnt lgkmcnt(0)\n\ts_barrier" ::: "memory");
#undef DMA_K
#undef DMA_V
#undef CMASK
#undef CINIT
#undef START
#undef RESC
#undef ROT
}
#undef SBAR
#undef WAIT_BAR
}


namespace down_body {
using bf16x8 = __attribute__((ext_vector_type(8))) short;
using f32x16 = __attribute__((ext_vector_type(16))) float;
using u32x4 = __attribute__((ext_vector_type(4))) unsigned;
__device__ __forceinline__ void glds16(const void* gsrc, unsigned lds_dst) { unsigned keep;
    asm volatile("s_mov_b32 %0, m0\n\ts_mov_b32 m0, %2\n\ts_nop 0\n\tglobal_load_lds_dwordx4 %1, off\n\ts_mov_b32 m0, %0" : "=&s"(keep) : "v"(gsrc), "s"(lds_dst) : "memory"); }
typedef float f32x2_t __attribute__((ext_vector_type(2))); typedef __bf16 bf16x2_t __attribute__((ext_vector_type(2)));
__device__ __forceinline__ unsigned cvtpk(float lo, float hi) { f32x2_t v = {lo, hi}; bf16x2_t b = __builtin_convertvector(v, bf16x2_t); return __builtin_bit_cast(unsigned, b); }
__device__ __forceinline__ void glds4(const void* gsrc, unsigned lds_dst) { unsigned keep;
    asm volatile("s_mov_b32 %0, m0\n\ts_mov_b32 m0, %2\n\ts_nop 0\n\tglobal_load_lds_dword %1, off\n\ts_mov_b32 m0, %0" : "=&s"(keep) : "v"(gsrc), "s"(lds_dst) : "memory"); }
__device__ __forceinline__ void down_phase(char* shm, __attribute__((address_space(3))) int* tkL, const __attribute__((address_space(3))) int* cnt, const __attribute__((address_space(3))) int* pbase,
                                           const int G, const int bx, const unsigned short* HID, const unsigned short* WD, const int* TOKL, unsigned short* Y2, unsigned short* sink) {
    typedef __attribute__((address_space(3))) const char* lds_cptr;
    int tid_ = threadIdx.x; asm volatile("" : "+v"(tid_));
    const int tid = tid_, lane = tid & 63, r32 = lane & 31, hi = lane >> 5; const int wid = __builtin_amdgcn_readfirstlane(tid >> 6);
    const unsigned lds0 = (unsigned)(uintptr_t)shm, ldstk = (unsigned)(uintptr_t)tkL;
    const lds_cptr rdbase = (lds_cptr)shm + r32 * 512 + 16 * (hi ^ (r32 & 1));
    const int rm = r32 >> 1;
    const int drow0 = 2 * wid + hi, drow1 = drow0 + 16;
    const unsigned dsrc0 = drow0 * 256 + ((r32 ^ drow0) & 31) * 8, dsrc1 = drow1 * 256 + ((r32 ^ drow1) & 31) * 8;
    const int wcol = 16 * ((r32 >> 2) & 1) + (r32 & 3) + 4 * (r32 >> 3);
    const int x = bx & 7, W = G >> 3, rk = bx >> 3;
    int J = 0;
#pragma unroll
    for (int k = 0; k < 4; ++k) J += 4 * ((__builtin_amdgcn_readfirstlane(cnt[x + 8 * k]) + 31) >> 5);
    const int chunk = (J + W - 1) / W, j0 = rk * chunk, j1 = (j0 + chunk < J) ? j0 + chunk : J;
    int pos = 0;
#pragma unroll 1
    for (int kp = 0; kp < 16; ++kp) {
        const int e = x + 8 * (kp >> 2), pn = kp & 3; const int cn = __builtin_amdgcn_readfirstlane(cnt[e]); const int Tk = (cn + 31) >> 5;
        const int t0 = (j0 > pos ? j0 : pos) - pos, t1 = (j1 < pos + Tk ? j1 : pos + Tk) - pos; pos += Tk;
        if (t0 >= t1) continue;
        const int n = t1 - t0;
        const unsigned short* wrow = WD + ((size_t)e * 1024 + pn * 256 + 32 * wid + wcol) * 256 + hi * 8;
        bf16x8 wfr[16];
#pragma unroll
        for (int ks = 0; ks < 16; ++ks) wfr[ks] = *(const bf16x8*)(wrow + ks * 16);
        const unsigned short* hbase = HID + ((size_t)__builtin_amdgcn_readfirstlane(pbase[e]) * 256 + 32 * t0) * 256;
        const int* tsrc = TOKL + (size_t)e * LCAP + 32 * t0 + r32;
        unsigned short* ycol = Y2 + pn * 256 + 32 * wid + 16 * hi;
        const int rows_left = cn - 32 * t0 - r32;
#define DN_DMA(tl, buf) do { const int tc_ = (tl) < n ? (tl) : n - 1; const unsigned short* s_ = hbase + (size_t)tc_ * (32 * 256); \
        glds16(s_ + dsrc0, (unsigned)__builtin_amdgcn_readfirstlane(lds0 + (buf) * 16384 + wid * 1024)); \
        glds16(s_ + dsrc1, (unsigned)__builtin_amdgcn_readfirstlane(lds0 + (buf) * 16384 + (wid + 8) * 1024)); \
        glds4(tsrc + tc_ * 32, (unsigned)__builtin_amdgcn_readfirstlane(ldstk + (buf) * 256)); } while (0)
        DN_DMA(0, 0); DN_DMA(1, 1); DN_DMA(2, 2); DN_DMA(3, 3); DN_DMA(4, 4);
        asm volatile("s_waitcnt vmcnt(12) lgkmcnt(0)\n\ts_barrier" ::: "memory");
        bf16x8 hfA[8], hfB[8];
#pragma unroll
        for (int ks = 0; ks < 8; ++ks) hfA[ks] = *(const __attribute__((address_space(3))) bf16x8*)(rdbase + 32 * (ks ^ rm));
#pragma unroll 1
        for (int j = 0; j < n; ++j) { const int bo = (j & 7) * 16384, bn = ((j + 1) & 7) * 16384;
#pragma unroll
            for (int ks = 0; ks < 8; ++ks) hfB[ks] = *(const __attribute__((address_space(3))) bf16x8*)(rdbase + bo + 32 * ((ks + 8) ^ rm));
            const int tk = tkL[(j & 7) * 64 + r32];
            __builtin_amdgcn_sched_barrier(0);
            f32x16 acc = f32x16{};
#pragma unroll
            for (int ks = 0; ks < 8; ++ks) acc = __builtin_amdgcn_mfma_f32_32x32x16_bf16(wfr[ks], hfA[ks], acc, 0, 0, 0);
            __builtin_amdgcn_sched_barrier(0);
            if (j >= 4) asm volatile("s_waitcnt vmcnt(17)\n\ts_barrier" ::: "memory");
            else if (j == 0) asm volatile("s_waitcnt vmcnt(9)\n\ts_barrier" ::: "memory");
            else if (j == 1) asm volatile("s_waitcnt vmcnt(11)\n\ts_barrier" ::: "memory");
            else if (j == 2) asm volatile("s_waitcnt vmcnt(13)\n\ts_barrier" ::: "memory");
            else asm volatile("s_waitcnt vmcnt(15)\n\ts_barrier" ::: "memory");
#pragma unroll
            for (int ks = 0; ks < 8; ++ks) hfA[ks] = *(const __attribute__((address_space(3))) bf16x8*)(rdbase + bn + 32 * (ks ^ rm));
            __builtin_amdgcn_sched_barrier(0);
#pragma unroll
            for (int ks = 0; ks < 8; ++ks) acc = __builtin_amdgcn_mfma_f32_32x32x16_bf16(wfr[ks + 8], hfB[ks], acc, 0, 0, 0);
            __builtin_amdgcn_sched_barrier(0);
            DN_DMA(j + 5, (j + 5) & 7);
            unsigned short* orow = (32 * j < rows_left) ? ycol + (size_t)tk * 1024 : sink + 16 * hi;
            u32x4 o0, o1;
            o0.x = cvtpk(acc[0], acc[1]);  o0.y = cvtpk(acc[2], acc[3]);  o0.z = cvtpk(acc[4], acc[5]);  o0.w = cvtpk(acc[6], acc[7]);
            o1.x = cvtpk(acc[8], acc[9]);  o1.y = cvtpk(acc[10], acc[11]); o1.z = cvtpk(acc[12], acc[13]); o1.w = cvtpk(acc[14], acc[15]);
            *(u32x4*)orow = o0; *(u32x4*)(orow + 8) = o1;
        }
#undef DN_DMA
        asm volatile("s_waitcnt vmcnt(0) lgkmcnt(0)\n\ts_barrier" ::: "memory");
    }
}
}

#define XB_TMO      128
#define XB_XCNT(j)  (256  + 64 * (j))
#define XB_XSUB(j)  (1280 + 64 * (j))
#define XB_XGEN(j)  (2304 + 64 * (j))
#define XB_TOP      3328
#define XB_TOPGEN   3392
#define XCD_BAR_WORDS 3456
#define XB_SPIN_CAP (1u << 18)
__device__ __forceinline__ unsigned xb_ld(unsigned* p)              { return __hip_atomic_load(p, __ATOMIC_RELAXED, __HIP_MEMORY_SCOPE_AGENT); }
__device__ __forceinline__ unsigned xb_add(unsigned* p, unsigned v) { return __hip_atomic_fetch_add(p, v, __ATOMIC_RELAXED, __HIP_MEMORY_SCOPE_AGENT); }
__device__ __forceinline__ unsigned xb_xcc_id() { return (unsigned)__builtin_amdgcn_s_getreg((3 << 11) | 20) & 0xFu; }
#define XB_SPIN(cond, bar) do { unsigned _sp = 0; while (cond) { __builtin_amdgcn_s_sleep(1); \
    if ((++_sp & 255u) == 0u) { if (xb_ld(&(bar)[XB_TMO])) break; if (_sp > XB_SPIN_CAP) { atomicAdd(&(bar)[XB_TMO], 1u); break; } } } } while (0)
struct XcdBarrier { unsigned* bar; unsigned x; volatile LAS unsigned* st; };
__device__ __forceinline__ XcdBarrier xcd_barrier_post(unsigned* bar, volatile LAS unsigned* st) {
    XcdBarrier b; b.bar = bar; b.x = xb_xcc_id(); b.st = st;
    if (threadIdx.x == 0) (void)xb_add(&bar[XB_XCNT(b.x)], 1u);
    return b;
}
__device__ __forceinline__ void xcd_barrier_complete(unsigned* bar, unsigned x, unsigned& nloc, unsigned& nx) {
    const unsigned G = gridDim.x * gridDim.y * gridDim.z;
    unsigned sum, cnt, mine, sp = 0u;
    for (;;) {
        sum = 0u; cnt = 0u; mine = 0u;
#pragma unroll
        for (unsigned j = 0; j < 16; ++j) { const unsigned c = xb_ld(&bar[XB_XCNT(j)]); sum += c; cnt += (c > 0u) ? 1u : 0u; mine = (j == x) ? c : mine; }
        if (sum == G) break;
        __builtin_amdgcn_s_sleep(1);
        if ((++sp & 255u) == 0u) { if (xb_ld(&bar[XB_TMO])) break; if (sp > XB_SPIN_CAP) { atomicAdd(&bar[XB_TMO], 1u); break; } }
    }
    nloc = mine > 0u ? mine : 1u; nx = cnt > 0u ? cnt : 1u;
}
__device__ __forceinline__ void xcd_barrier(const XcdBarrier& b) {
    asm volatile("s_waitcnt vmcnt(0)" ::: "memory");
    __syncthreads();
    if (threadIdx.x == 0) {
        unsigned* bar = b.bar;
        __builtin_amdgcn_s_waitcnt(0);
        unsigned nloc = b.st[0], nx = b.st[1];
        if (nloc == 0u) { xcd_barrier_complete(bar, b.x, nloc, nx); b.st[0] = nloc; b.st[1] = nx; }
        const unsigned old = xb_add(&bar[XB_XSUB(b.x)], 1u);
        const unsigned gen = old / nloc;
        if (old + 1u == (gen + 1u) * nloc) {
            __builtin_amdgcn_fence(__ATOMIC_RELEASE, "agent");
            asm volatile("s_waitcnt vmcnt(0)" ::: "memory");
            const unsigned og = xb_add(&bar[XB_TOP], 1u);
            const unsigned tg = og / nx;
            if (og + 1u == (tg + 1u) * nx) xb_add(&bar[XB_TOPGEN], 1u);
            else XB_SPIN(xb_ld(&bar[XB_TOPGEN]) == tg, bar);
            __builtin_amdgcn_fence(__ATOMIC_ACQUIRE, "agent");
            xb_add(&bar[XB_XGEN(b.x)], 1u);
            asm volatile("s_waitcnt vmcnt(0)" ::: "memory");
        } else {
            XB_SPIN(xb_ld(&bar[XB_XGEN(b.x)]) == gen, bar);
            __builtin_amdgcn_fence(__ATOMIC_ACQUIRE, "agent");
            asm volatile("s_waitcnt vmcnt(0)" ::: "memory");
        }
    }
    __syncthreads();
}

struct Args {
    const float *x, *c, *w_ada, *b_ada, *g_mix, *g_ffn, *w_in, *sinks, *b_forget, *w_pa, *w_pb, *w_out, *rel, *w_rg, *b_rg, *w_re, *b_re, *w_g, *w_u, *w_d, *g_final;
    float* out; unsigned char* ws; int ph_lo, ph_hi;
};

__device__ __forceinline__ void transpose_item(const float* W, int ldw, int K, int k0, int srccol0, bf16* WT, int dstrow0, LAS float* scr, int lane) {
#pragma unroll 8
    for (int i = 0; i < 32; ++i) { const int kk = 2 * i + (lane >> 5); scr[kk * 33 + (lane & 31)] = W[(size_t)(k0 + kk) * ldw + srccol0 + (lane & 31)]; }
    LDS_WAIT(); asm volatile("" ::: "memory");
    const int c = lane & 7;
#pragma unroll
    for (int j = 0; j < 4; ++j) { const int n = (lane >> 3) + 8 * j; const LAS float* s = scr + (8 * c) * 33 + n;
        v4u o; o.x = pk2(s[0 * 33], s[1 * 33]); o.y = pk2(s[2 * 33], s[3 * 33]); o.z = pk2(s[4 * 33], s[5 * 33]); o.w = pk2(s[6 * 33], s[7 * 33]);
        *(GAS v4u*)(WT + (size_t)(dstrow0 + n) * K + k0 + 8 * c) = o; }
    LDS_WAIT(); asm volatile("" ::: "memory");
}

__device__ __forceinline__ int t5_bucket(int n) {
    if (n < 16) return n;
    int large = 16 + (int)(logf((float)n / 16.0f) / logf(8.0f) * 16.0f);
    return large < 31 ? large : 31;
}

__global__ void __launch_bounds__(NWAVES * 64, 2) fwd_kernel(Args args) {
    extern __shared__ __attribute__((aligned(16))) unsigned char lds[];
    LAS unsigned char* const L = (LAS unsigned char*)lds;
    volatile LAS unsigned* const MISC = (volatile LAS unsigned*)(L + MISC_OFF);
    const int tid = threadIdx.x, lane = tid & 63, wave = __builtin_amdgcn_readfirstlane(tid >> 6);
    const int G = gridDim.x, bx = blockIdx.x;
    const int vcu = (G % 8 == 0) ? (bx % 8) * (G / 8) + bx / 8 : bx;
    unsigned char* const ws = args.ws;
    unsigned* const ctl = (unsigned*)(ws + WS_CTL);
    float* const MOD = (float*)(ws + WS_MOD);
    float* const LOGF = (float*)(ws + WS_LOGF);
    float* const CUM = (float*)(ws + WS_CUM);
    float* const SWAT = (float*)(ws + WS_SWAT);
    int* const TOKL = (int*)(ws + WS_TOKL);
    float* const WLST = (float*)(ws + WS_WL);
    bf16* const WIN = (bf16*)(ws + WS_WIN); bf16* const WPA = (bf16*)(ws + WS_WPA); bf16* const WPB = (bf16*)(ws + WS_WPB); bf16* const WOUT = (bf16*)(ws + WS_WOUT);
    bf16* const WGU = (bf16*)(ws + WS_WGU); bf16* const WD = (bf16*)(ws + WS_WD);
    bf16* const HB = (bf16*)(ws + WS_H); bf16* const RB = (bf16*)(ws + WS_R); bf16* const GBB = (bf16*)(ws + WS_GB); bf16* const Y2 = (bf16*)(ws + WS_Y2);
    bf16* const PB = (bf16*)(ws + WS_P); bf16* const HID = (bf16*)(ws + WS_HID);
    bf16* const X1 = (bf16*)(ws + WS_X1);
    if (tid < 32) MISC[tid] = 0u;
    __syncthreads();
    XcdBarrier bar = xcd_barrier_post(ctl + CW_BAR, MISC + 8);
    const int lo = args.ph_lo, hi = args.ph_hi;
#define IN(k) (lo <= (k) && (k) < hi)
#define GRID_BAR(k) do { if (IN(k) && IN((k) + 1)) xcd_barrier(bar); } while (0)

    if (IN(0)) for (int rep_ = 0; rep_ < REPS(0); ++rep_) {
        if (rep_) __syncthreads();
        if (bx < 192) {
            LAS float* sc = (LAS float*)L; LAS float* red = (LAS float*)(L + 32768);
            for (int i = tid; i < 8192; i += 512) { const float v = args.c[i]; sc[i] = v / (1.f + expf(-v)); }
            __syncthreads();
            const int kg = tid >> 3, cq = tid & 7, col0 = 32 * bx;
            f32x4 a[8];
#pragma unroll
            for (int b = 0; b < 8; ++b) a[b] = (f32x4){0.f, 0.f, 0.f, 0.f};
            for (int k = kg; k < 1024; k += 64) { const f32x4 w4 = *(const f32x4*)(args.w_ada + (size_t)k * 6144 + col0 + 4 * cq);
#pragma unroll
                for (int b = 0; b < 8; ++b) a[b] += sc[b * 1024 + k] * w4; }
#pragma unroll
            for (int b = 0; b < 8; ++b)
#pragma unroll
                for (int j = 0; j < 4; ++j) red[(kg * 8 + b) * 32 + cq * 4 + j] = a[b][j];
            __syncthreads();
            if (tid < 256) { const int b = tid >> 5, j = tid & 31; float s = 0.f; for (int g = 0; g < 64; ++g) s += red[(g * 8 + b) * 32 + j]; MOD[b * 6144 + col0 + j] = s + args.b_ada[col0 + j]; }
            __syncthreads();
        } else if (bx < 208) {
            const int i = (bx - 192) * 512 + tid; const int h = i >> 10, d = (i & 1023) - 256;
            SWAT[i] = (d >= 0 && d < 128) ? args.rel[t5_bucket(d) * 8 + h] * LOG2E : -INFINITY;
            if (i < 8) SWAT[8192 + i] = args.sinks[i] * LOG2E;
        }
        LAS float* scr = (LAS float*)(L + wave * 16384);
        const int gw = bx * NWAVES + wave, NGW = G * NWAVES;
        constexpr int I_IN = 136 * 16, I_PA = 32 * 8, I_OUT = 32 * 16;
        constexpr int NITEMS = I_IN + 2 * I_PA + I_OUT;
        for (int it = gw; it < NITEMS; it += NGW) {
            int r = it;
            if (r < I_IN) { const int rb = r >> 4, kb = r & 15; const int d0 = rb * 32; int s0;
                if (d0 < 2304) s0 = d0; else { const int t = (d0 - 2304) >> 8, w = (d0 - 2304) & 255; s0 = (w < 128) ? 2312 + 128 * t + w : 2312 + 1024 + 128 * t + (w - 128); }
                transpose_item(args.w_in, IN_COLS, 1024, kb * 64, s0, WIN, d0, scr, lane); continue; } r -= I_IN;
            if (r < I_PA) { const int rb = r >> 3, kb = r & 7; transpose_item(args.w_pa, 1024, 512, kb * 64, rb * 32, WPA, rb * 32, scr, lane); continue; } r -= I_PA;
            if (r < I_PA) { const int rb = r >> 3, kb = r & 7; transpose_item(args.w_pb, 1024, 512, kb * 64, rb * 32, WPB, rb * 32, scr, lane); continue; } r -= I_PA;
            { const int rb = r >> 4, kb = r & 15; transpose_item(args.w_out, 1024, 1024, kb * 64, rb * 32, WOUT, rb * 32, scr, lane); }
        }
    }
    GRID_BAR(0);

    if (IN(1)) for (int rep_ = 0; rep_ < REPS(1); ++rep_) {
        __syncthreads();
        LAS float* wf = (LAS float*)L;
        for (int s = tid; s < 8192; s += 512) { const int c = s >> 3, j = s & 7; wf[j * 1024 + c] = args.w_in[(size_t)c * IN_COLS + 2304 + j]; }
        __syncthreads();
        const int gw = bx * NWAVES + wave; const int row0 = gw * 16, b = row0 >> 12;
        const float* shift = MOD + b * 6144, *scale = MOD + b * 6144 + 1024;
        f32x4 fa[4], fb[4];
#pragma unroll
        for (int j = 0; j < 4; ++j) { const int c = 4 * lane + 256 * j; const f32x4 g = *(const f32x4*)(args.g_mix + c), s = *(const f32x4*)(scale + c); fa[j] = g * (1.f + s); fb[j] = *(const f32x4*)(shift + c); }
        for (int rr = 0; rr < 16; ++rr) { const int row = row0 + rr;
            const f32x4* xr = (const f32x4*)(args.x + (size_t)row * D) + lane;
            f32x4 v[4]; float ss = 0.f;
#pragma unroll
            for (int j = 0; j < 4; ++j) { v[j] = __builtin_nontemporal_load(xr + 64 * j); ss += (v[j].x * v[j].x + v[j].y * v[j].y) + (v[j].z * v[j].z + v[j].w * v[j].w); }
            const float rstd = 1.0f / sqrtf(wave_sum(ss) * (1.f / D) + EPS);
#pragma unroll
            for (int j = 0; j < 4; ++j) v[j] = v[j] * rstd * fa[j] + fb[j];
            unsigned long long* o8 = (unsigned long long*)(HB + (size_t)row * D) + lane;
#pragma unroll
            for (int j = 0; j < 4; ++j) o8[64 * j] = (unsigned long long)pk2(v[j].x, v[j].y) | ((unsigned long long)pk2(v[j].z, v[j].w) << 32);
            float mine = 0.f;
#pragma unroll
            for (int o = 0; o < 8; ++o) { float p = 0.f;
#pragma unroll
                for (int j = 0; j < 4; ++j) { const f32x4 w4 = *(const LAS f32x4*)(wf + o * 1024 + 4 * lane + 256 * j); p += (v[j].x * w4.x + v[j].y * w4.y) + (v[j].z * w4.z + v[j].w * w4.w); }
                p = wave_sum(p); if (lane == o) mine = p; }
            if (lane < 8) { const float z = mine + args.b_forget[lane]; const float ls = fminf(z, 0.f) - log1pf(expf(-fabsf(z))); LOGF[(size_t)row * 8 + lane] = ls; }
        }
    }
    GRID_BAR(1);
    if ((PROBE_MASK >> 11) & 1) { xcd_barrier(bar); xcd_barrier(bar); xcd_barrier(bar); xcd_barrier(bar); }

    if (IN(2)) for (int rep_ = 0; rep_ < REPS(2); ++rep_) {
        if (bx < 64) {
            __syncthreads();
            LAS float* wsum = (LAS float*)L;
            const int b = bx >> 3, h = bx & 7; float v[8]; float run = 0.f;
#pragma unroll
            for (int i = 0; i < 8; ++i) { run += LOGF[((size_t)b * SEQ + tid * 8 + i) * 8 + h]; v[i] = run; }
            float s = run;
#pragma unroll
            for (int o = 1; o < 64; o <<= 1) { const float t = __shfl_up(s, o); if (lane >= o) s += t; }
            if (lane == 63) wsum[wave] = s;
            __syncthreads();
            float off = s - run; for (int w = 0; w < wave; ++w) off += wsum[w];
#pragma unroll
            for (int i = 0; i < 8; ++i) CUM[(size_t)bx * SEQ + tid * 8 + i] = (off + v[i]) * LOG2E;
            __syncthreads();
        }
        pg8::SrcPlain src{(const char*)HB, (const char*)WIN, 2048u, 1024};
        pg8::StaticOrder S; S.init(M, NPROJ, G, bx);
        pg8::EpiProj E{PB, RB, GBB, ctl + CW_NRM};
        pg8::gemm_phase<pg8::EpiProj, pg8::StaticOrder, pg8::SrcPlain, true>(L + RING_OFF, src, S, E);
        if (G == 256 ? bx >= 128 : true) {
            constexpr int I_GU = 32 * 16 * 16, I_D = 32 * 32 * 4;
            LAS float* scr = (LAS float*)(L + wave * 16384);
            const int w0 = (G == 256) ? (bx - 128) * NWAVES + wave : bx * NWAVES + wave, nw = (G == 256) ? 128 * NWAVES : G * NWAVES;
            for (int it = w0; it < I_GU + I_D; it += nw) {
                int r = it;
                if (r < I_GU) { const int e = r >> 8, q = r & 255, rb = q >> 4, kb = q & 15; const int d0 = rb * 32, pn = d0 >> 8, w = d0 & 255;
                    const float* src = (w < 128) ? args.w_g : args.w_u; const int s0 = 128 * pn + (w & 127);
                    transpose_item(src + (size_t)e * 1024 * 256, 256, 1024, kb * 64, s0, WGU + (size_t)e * 512 * 1024, d0, scr, lane); continue; } r -= I_GU;
                { const int e = r >> 7, q = r & 127, rb = q >> 2, kb = q & 3;
                  transpose_item(args.w_d + (size_t)e * 256 * 1024, 1024, 256, kb * 64, rb * 32, WD + (size_t)e * 1024 * 256, rb * 32, scr, lane); }
            }
        }
    }
    GRID_BAR(2);

    if (IN(3)) {
        if (G == 256) {
            const int xb = bx & 7; unsigned* const qh = ctl + CW_QH + xb * 32; volatile LAS int* const qslot = (volatile LAS int*)(L + MISC_OFF) + 16;
            if (tid == 0) qslot[0] = (int)__hip_atomic_fetch_add(qh, 1u, RLX_AGENT);
            __syncthreads();
            for (int rep_ = 0; rep_ < REPS(3); ++rep_)
            for (;;) { const int idx = __builtin_amdgcn_readfirstlane(qslot[0]); if (idx >= 128) break;
                const int hq = idx & 7, qb = 15 - (idx >> 3);
                const unsigned* nr = ctl + CW_NRM + (xb * 8 + hq) * 4;
                const float q2 = __uint_as_float(nr[0]) + __uint_as_float(nr[1]), k2 = __uint_as_float(nr[2]) + __uint_as_float(nr[3]);
                const float thr = -(160.f + 2.1f * sqrtf(q2 * k2));
                attn_body::attn_unit<0, 8>(xb, hq, qb, (attn_body::bf16*)PB, CUM, 0.f, (char*)lds + RING_OFF, true, thr, qh, qslot); }
            __syncthreads();
            if (tid == 0) qslot[0] = (int)__hip_atomic_fetch_add(qh + 16, 1u, RLX_AGENT);
            __syncthreads();
            for (int rep_ = 0; rep_ < REPS(10); ++rep_)
            for (;;) { const int idx = __builtin_amdgcn_readfirstlane(qslot[0]); if (idx >= 128) break;
                const int hq = (idx & 3) * 2, qb = idx >> 2;
                attn_body::attn_unit<1, 8>(xb, hq, qb, (attn_body::bf16*)PB, SWAT, 0.f, (char*)lds + RING_OFF, true, 0.f, qh + 16, qslot); }
        }
    }
    GRID_BAR(3);

    if (IN(4)) for (int rep_ = 0; rep_ < REPS(4); ++rep_) {
        pg8::SrcSeg src{(const char*)PB, (const char*)WPA, (const char*)WPB, (unsigned)(PP * 2), (unsigned)(C_QA * 2), (unsigned)(C_QB * 2), 512};
        pg8::SegOrder S; S.base.init(M, D, G, bx);
        pg8::EpiMerge E{RB, GBB, (bf16*)(ws + WS_MGP)};
        pg8::gemm_phase<pg8::EpiMerge, pg8::SegOrder, pg8::SrcSeg, true>(L + RING_OFF, src, S, E);
    }
    GRID_BAR(4);

    if (IN(5)) for (int rep_ = 0; rep_ < REPS(5); ++rep_) {
        pg8::SrcPlain src{(const char*)(ws + WS_MGP), (const char*)WOUT, (unsigned)(MGP * 2), 1024};
        pg8::StaticOrder S; S.init(M, D, G, bx);
        pg8::EpiResid E{args.x, MOD, X1};
        pg8::gemm_phase<pg8::EpiResid, pg8::StaticOrder, pg8::SrcPlain, true>(L + RING_OFF, src, S, E);
    }
    GRID_BAR(5);

    if (IN(6)) for (int rep_ = 0; rep_ < REPS(6); ++rep_) {
        __syncthreads();
        LAS float* Wr = (LAS float*)L;
        LAS int* peL = (LAS int*)(L + P5_PE_OFF); LAS float* pwL = (LAS float*)(L + P5_PW_OFF); LAS int* lcount = (LAS int*)(L + P5_LC_OFF); LAS int* gbase = (LAS int*)(L + P5_GB_OFF);
        LAS float* lgs = (LAS float*)(L + P5_LG_OFF) + wave * 160; LAS float* facA = (LAS float*)(L + P5_FA_OFF); LAS float* facB = (LAS float*)(L + P5_FB_OFF);
        const int b = (bx * 128) >> 12;
        for (int c = tid; c < 1024; c += 512) { const f32x4 w = *(const f32x4*)(args.w_rg + 4 * c); Wr[c] = w.x; Wr[1024 + c] = w.y; Wr[2048 + c] = w.z; Wr[3072 + c] = w.w; }
        for (int it = tid; it < 4096; it += 512) { const int g = it >> 10, c = it & 1023; const f32x4 wa = *(const f32x4*)(args.w_re + (size_t)it * 8), wb = *(const f32x4*)(args.w_re + (size_t)it * 8 + 4);
            LAS float* d = Wr + (4 + g * 8) * 1024 + c; d[0] = wa.x; d[1024] = wa.y; d[2048] = wa.z; d[3072] = wa.w; d[4096] = wb.x; d[5120] = wb.y; d[6144] = wb.z; d[7168] = wb.w; }
        for (int c = tid; c < 1024; c += 512) { facA[c] = args.g_ffn[c] * (1.f + MOD[b * 6144 + 4096 + c]); facB[c] = MOD[b * 6144 + 3072 + c]; }
        if (tid < 32) lcount[tid] = 0;
        __syncthreads();
        v2u raw[4][4];
#pragma unroll
        for (int r = 0; r < 4; ++r) { const v2u* xr = (const v2u*)(X1 + (size_t)(bx * 128 + wave * 16 + r) * D) + lane;
#pragma unroll
            for (int j = 0; j < 4; ++j) raw[r][j] = xr[64 * j]; }
        for (int grp = 0; grp < 4; ++grp) { const int lrow0 = wave * 16 + grp * 4; const int row0 = bx * 128 + lrow0;
            f32x4 v[4][4];
#pragma unroll
            for (int r = 0; r < 4; ++r)
#pragma unroll
                for (int j = 0; j < 4; ++j) { const v2u xw = raw[r][j]; v[r][j] = (f32x4){bflo(xw.x), bfhi(xw.x), bflo(xw.y), bfhi(xw.y)}; }
            if (grp < 3) {
#pragma unroll
                for (int r = 0; r < 4; ++r) { const v2u* xr = (const v2u*)(X1 + (size_t)(row0 + 4 + r) * D) + lane;
#pragma unroll
                    for (int j = 0; j < 4; ++j) raw[r][j] = xr[64 * j]; } }
#pragma unroll
            for (int r = 0; r < 4; ++r) { float ss = 0.f;
#pragma unroll
                for (int j = 0; j < 4; ++j) { ss += (v[r][j].x * v[r][j].x + v[r][j].y * v[r][j].y) + (v[r][j].z * v[r][j].z + v[r][j].w * v[r][j].w); }
                const float rstd = 1.0f / sqrtf(wave_sum(ss) * (1.f / D) + EPS);
                unsigned long long* o8 = (unsigned long long*)(HB + (size_t)(row0 + r) * D) + lane;
#pragma unroll
                for (int j = 0; j < 4; ++j) { const f32x4 fa = *(const LAS f32x4*)(facA + 4 * lane + 256 * j), fb = *(const LAS f32x4*)(facB + 4 * lane + 256 * j);
                    v[r][j] = v[r][j] * rstd * fa + fb; o8[64 * j] = (unsigned long long)pk2(v[r][j].x, v[r][j].y) | ((unsigned long long)pk2(v[r][j].z, v[r][j].w) << 32); } }
#define P5_DOT(ROWS, WPTR, OUT) do { f32x2v a2_[4]; \
                _Pragma("unroll") for (int r_ = 0; r_ < 4; ++r_) a2_[r_] = (f32x2v){0.f, 0.f}; \
                _Pragma("unroll") for (int j_ = 0; j_ < 4; ++j_) { const f32x4 w4_ = *(const LAS f32x4*)((WPTR) + 256 * j_); const f32x2v wl_ = {w4_.x, w4_.y}, wh_ = {w4_.z, w4_.w}; \
                    _Pragma("unroll") for (int r_ = 0; r_ < 4; ++r_) if ((ROWS) & (1 << r_)) { a2_[r_] += (f32x2v){v[r_][j_].x, v[r_][j_].y} * wl_; a2_[r_] += (f32x2v){v[r_][j_].z, v[r_][j_].w} * wh_; } } \
                _Pragma("unroll") for (int r_ = 0; r_ < 4; ++r_) OUT[r_] = a2_[r_].x + a2_[r_].y; } while (0)
#define P5_SWAP32(A, B) ({ auto rr_ = __builtin_amdgcn_permlane32_swap(__float_as_uint(A), __float_as_uint(B), false, false); __uint_as_float(rr_[0]) + __uint_as_float(rr_[1]); })
#define P5_SWAP16(A, B) ({ auto rr_ = __builtin_amdgcn_permlane16_swap(__float_as_uint(A), __float_as_uint(B), false, false); __uint_as_float(rr_[0]) + __uint_as_float(rr_[1]); })
#define P5_ROW16(Z) do { Z += dpp_f(Z, 0xB1); Z += dpp_f(Z, 0x4E); Z += dpp_f(Z, 0x141); Z += dpp_f(Z, 0x140); } while (0)
            const int q_ = lane >> 4, sub_ = (q_ == 1) ? 2 : (q_ == 2) ? 1 : q_;
            { float X[16];
#pragma unroll
                for (int g = 0; g < 4; ++g) { float o_[4]; P5_DOT(15, Wr + g * 1024 + 4 * lane, o_);
#pragma unroll
                    for (int r = 0; r < 4; ++r) X[r * 4 + g] = o_[r]; }
                float Y[8], Z[4];
#pragma unroll
                for (int m = 0; m < 8; ++m) Y[m] = P5_SWAP32(X[2 * m], X[2 * m + 1]);
#pragma unroll
                for (int n = 0; n < 4; ++n) { Z[n] = P5_SWAP16(Y[2 * n], Y[2 * n + 1]); P5_ROW16(Z[n]); }
                if ((lane & 15) == 0) {
#pragma unroll
                    for (int n = 0; n < 4; ++n) { const int i = 4 * n + sub_; lgs[(i >> 2) * 40 + (i & 3)] = Z[n]; } } }
            LDS_WAIT(); asm volatile("" ::: "memory");
            int gsel[4];
#pragma unroll
            for (int r = 0; r < 4; ++r) { float best = lgs[r * 40] + args.b_rg[0]; int gi_ = 0;
#pragma unroll
                for (int g = 1; g < 4; ++g) { const float z = lgs[r * 40 + g] + args.b_rg[g]; if (z > best) { best = z; gi_ = g; } }
                gsel[r] = __builtin_amdgcn_readfirstlane(gi_); }
            { float X[32];
#pragma unroll
                for (int r = 0; r < 4; ++r) { const LAS float* wbase = Wr + (4 + gsel[r] * 8) * 1024 + 4 * lane;
#pragma unroll
                    for (int e = 0; e < 8; ++e) { f32x2v a2_ = {0.f, 0.f};
#pragma unroll
                        for (int j = 0; j < 4; ++j) { const f32x4 w4_ = *(const LAS f32x4*)(wbase + e * 1024 + 256 * j);
                            a2_ += (f32x2v){v[r][j].x, v[r][j].y} * (f32x2v){w4_.x, w4_.y}; a2_ += (f32x2v){v[r][j].z, v[r][j].w} * (f32x2v){w4_.z, w4_.w}; }
                        X[r * 8 + e] = a2_.x + a2_.y; } }
                float Y[16], Z[8];
#pragma unroll
                for (int m = 0; m < 16; ++m) Y[m] = P5_SWAP32(X[2 * m], X[2 * m + 1]);
#pragma unroll
                for (int n = 0; n < 8; ++n) { Z[n] = P5_SWAP16(Y[2 * n], Y[2 * n + 1]); P5_ROW16(Z[n]); }
                if ((lane & 15) == 0) {
#pragma unroll
                    for (int n = 0; n < 8; ++n) { const int i = 4 * n + sub_; lgs[(i >> 3) * 40 + 4 + (i & 7)] = Z[n]; } } }
#undef P5_DOT
#undef P5_SWAP32
#undef P5_SWAP16
#undef P5_ROW16
            LDS_WAIT(); asm volatile("" ::: "memory");
            if (lane < 4) { const LAS float* lg = lgs + lane * 40;
                float gl[4]; int gi = 0; float gmax;
#pragma unroll
                for (int j = 0; j < 4; ++j) gl[j] = lg[j] + args.b_rg[j];
                gmax = gl[0];
#pragma unroll
                for (int j = 1; j < 4; ++j) if (gl[j] > gmax) { gmax = gl[j]; gi = j; }
                float den = 0.f;
#pragma unroll
                for (int j = 0; j < 4; ++j) den += expf(gl[j] - gmax);
                const float gp = 1.f / den;
                float v1 = -INFINITY, v2 = -INFINITY; int e1 = 0, e2 = 0;
                for (int e = 0; e < 8; ++e) { const float z = lg[4 + e] + args.b_re[gi * 8 + e];
                    if (z > v1) { v2 = v1; e2 = e1; v1 = z; e1 = e; } else if (z > v2) { v2 = z; e2 = e; } }
                const float t2 = expf(v2 - v1); const float w1 = gp / (1.f + t2), w2 = gp * t2 / (1.f + t2);
                const int lr = lrow0 + lane;
                peL[lr * 2] = gi * 8 + e1; peL[lr * 2 + 1] = gi * 8 + e2; pwL[lr * 2] = w1; pwL[lr * 2 + 1] = w2; }
            LDS_WAIT(); asm volatile("" ::: "memory");
        }
        __syncthreads();
        if (rep_ != REPS(6) - 1) continue;
        int my_e = 0, my_lr = 0;
        if (tid < 256) { my_e = peL[tid]; my_lr = __hip_atomic_fetch_add(lcount + my_e, 1, __ATOMIC_RELAXED, __HIP_MEMORY_SCOPE_WORKGROUP); }
        __syncthreads();
        if (tid < 32) { const int n = lcount[tid]; gbase[tid] = n ? (int)__hip_atomic_fetch_add(ctl + CW_CNT + tid * 16, (unsigned)n, RLX_AGENT) : 0; }
        __syncthreads();
        if (tid < 256) { const int slot = gbase[my_e] + my_lr; if (slot < LCAP) {
            __hip_atomic_store((unsigned*)TOKL + (size_t)my_e * LCAP + slot, (unsigned)((bx * 128 + (tid >> 1)) * 2 + (tid & 1)), RLX_AGENT);
            __hip_atomic_store((unsigned*)WLST + (size_t)my_e * LCAP + slot, __builtin_bit_cast(unsigned, (float)pwL[tid]), RLX_AGENT); } }
    }
    GRID_BAR(6);

    if (IN(7) || IN(8)) {
        __syncthreads();
        LAS int* cntL = (LAS int*)(L + MOE_CNT_OFF); LAS int* pbase = (LAS int*)(L + MOE_PB_OFF); LAS int* tokL = (LAS int*)(L + MOE_TOK_OFF);
        if (tid < 32) { int n = (int)__hip_atomic_load(ctl + CW_CNT + tid * 16, RLX_AGENT); cntL[tid] = n < LCAP ? n : LCAP; }
        __syncthreads();
        if (tid == 0) { int p = 0; for (int e = 0; e < 32; ++e) { pbase[e] = p; p += (cntL[e] + 255) >> 8; } pbase[32] = p; }
        __syncthreads();
        if (IN(7)) for (int rep_ = 0; rep_ < REPS(7); ++rep_) {
            pg8::MoeOrder S{pbase, 1, G, bx};
            { pg8::Unit u; for (int i = 0; i < 15 && S.next(i, u); ++i) { if (tid < 256) { const int slot = u.seg * 256 + tid; tokL[i * 256 + tid] = (slot < cntL[u.e]) ? TOKL[(size_t)u.e * LCAP + slot] : 0; } } }
            __syncthreads();
            pg8::SrcMoe1 src{(const char*)HB, (const char*)WGU, tokL, 1024};
            pg8::EpiHid E{WLST, cntL, HID};
            pg8::gemm_phase<pg8::EpiHid, pg8::MoeOrder, pg8::SrcMoe1, true>(L + RING_OFF, src, S, E);
        }
        GRID_BAR(7);
        if (IN(8)) for (int rep_ = 0; rep_ < REPS(8); ++rep_) {
            down_body::down_phase((char*)lds + RING_OFF, tokL, cntL, pbase, G, bx, HID, WD, TOKL, Y2, (bf16*)(ws + WS_DUMMY));
        }
    }
    GRID_BAR(8);

    if (IN(9)) for (int rep_ = 0; rep_ < REPS(9); ++rep_) {
        const int gw = bx * NWAVES + wave; const int row0 = gw * 16, b = row0 >> 12;
        const float* gf = MOD + b * 6144 + 5120;
        f32x4 g4[4], gn[4];
#pragma unroll
        for (int j = 0; j < 4; ++j) { g4[j] = *(const f32x4*)(gf + 4 * lane + 256 * j); gn[j] = *(const f32x4*)(args.g_final + 4 * lane + 256 * j); }
        for (int rr = 0; rr < 16; ++rr) { const int row = row0 + rr;
            const v2u* xr = (const v2u*)(X1 + (size_t)row * D) + lane;
            f32x4* xo = (f32x4*)(args.out + (size_t)row * D) + lane;
            const v2u* y0 = (const v2u*)(Y2 + (size_t)(2 * row) * D) + lane; const v2u* y1 = (const v2u*)(Y2 + (size_t)(2 * row + 1) * D) + lane;
            f32x4 v[4]; float ss = 0.f;
#pragma unroll
            for (int j = 0; j < 4; ++j) { const v2u a = y0[64 * j], c = y1[64 * j]; const f32x4 ya = {bflo(a.x), bfhi(a.x), bflo(a.y), bfhi(a.y)}, yc = {bflo(c.x), bfhi(c.x), bflo(c.y), bfhi(c.y)};
                const v2u xw = xr[64 * j]; v[j] = (f32x4){bflo(xw.x), bfhi(xw.x), bflo(xw.y), bfhi(xw.y)} + g4[j] * (ya + yc); ss += (v[j].x * v[j].x + v[j].y * v[j].y) + (v[j].z * v[j].z + v[j].w * v[j].w); }
            const float rstd = 1.0f / sqrtf(wave_sum(ss) * (1.f / D) + EPS);
#pragma unroll
            for (int j = 0; j < 4; ++j) __builtin_nontemporal_store(v[j] * rstd * gn[j], xo + 64 * j);
        }
    }
#undef IN
#undef GRID_BAR
}

extern "C" void kernel_launch(void* const* d_in, const int* in_sizes, int n_in, void* d_out, int out_size, void* d_ws, size_t ws_size, hipStream_t stream) {
    static int grid = 0;
    if (grid == 0) {
        if (n_in != 21 || in_sizes[0] != M * D || out_size != M * D || ws_size < WS_END) { fprintf(stderr, "kernel_launch: unexpected shapes (n_in %d, in0 %d, out %d, ws %zu); nothing launched\n", n_in, n_in > 0 ? in_sizes[0] : -1, out_size, ws_size); grid = -1; return; }
        int dev = 0, cus = 0;
        if (hipGetDevice(&dev) != hipSuccess || hipDeviceGetAttribute(&cus, hipDeviceAttributeMultiprocessorCount, dev) != hipSuccess) { grid = -1; return; }
        if (hipFuncSetAttribute((const void*)fwd_kernel, hipFuncAttributeMaxDynamicSharedMemorySize, LDS_BYTES) != hipSuccess) { fprintf(stderr, "kernel_launch: hipFuncSetAttribute failed\n"); grid = -1; return; }
        int per_cu = 0;
        if (hipOccupancyMaxActiveBlocksPerMultiprocessor(&per_cu, (const void*)fwd_kernel, NWAVES * 64, LDS_BYTES) != hipSuccess || per_cu < 1) fprintf(stderr, "kernel_launch: occupancy query reports %d\n", per_cu);
        (void)hipGetLastError();
        grid = cus;
        if (grid != 256) { fprintf(stderr, "kernel_launch: built for 256 CUs, device has %d; nothing launched\n", cus); grid = -1; return; }
    }
    if (grid < 0) return;
    if (hipMemsetAsync((char*)d_ws + WS_CTL, 0, CTL_ZERO_BYTES, stream) != hipSuccess) return;
    Args a{};
    const float** ap = (const float**)&a;
    for (int i = 0; i < 21; ++i) ap[i] = (const float*)d_in[i];
    a.out = (float*)d_out; a.ws = (unsigned char*)d_ws; a.ph_lo = 0; a.ph_hi = 10;
    hipLaunchKernelGGL(fwd_kernel, dim3(grid), dim3(NWAVES * 64), LDS_BYTES, stream, a);
}
```

```cpp
#include <hip/hip_runtime.h>
#include <hip/hip_bf16.h>
#include <cstdio>
#include <cstdint>
#include <cmath>

#define LAS __attribute__((address_space(3)))
#define GAS __attribute__((address_space(1)))

constexpr int BATCH = 8, SEQ = 4096, D = 1024, M = BATCH * SEQ;
constexpr int IN_COLS = 4360, NPROJ = 4352;
constexpr int PP = 2304;
constexpr int C_QA = 0, C_KA = 512, C_VA = 640, C_QB = 768, C_KB = 1280, C_VB = 1792;
constexpr int NE = 32, FF = 256, LCAP = 32768, MAXPAN = 288;
constexpr float LOG2E = 1.4426950408889634f;
constexpr float C2 = 0.125f * LOG2E;
constexpr float EPS = 1e-6f;
constexpr int NWAVES = 8;
#ifndef PROBE_MASK
#define PROBE_MASK 0
#endif
#define REPS(k) (((PROBE_MASK >> (k)) & 1) ? 2 : 1)

constexpr size_t MiB = 1u << 20;
constexpr size_t WS_CTL = 0, CTL_ZERO_BYTES = 1 * MiB;
constexpr size_t WS_MOD = 1 * MiB;
constexpr size_t WS_LOGF = 2 * MiB;
constexpr size_t WS_CUM = 3 * MiB;
constexpr size_t WS_SWAT = 4 * MiB;
constexpr size_t WS_TOKL = 5 * MiB;
constexpr size_t WS_WL = 9 * MiB;
constexpr size_t WS_WIN = 16 * MiB;
constexpr size_t WS_WPA = 25 * MiB, WS_WPB = 26 * MiB, WS_WOUT = 27 * MiB;
constexpr size_t WS_WGU = 32 * MiB;
constexpr size_t WS_WD = 64 * MiB;
constexpr size_t WS_H = 80 * MiB;
constexpr size_t WS_R = 144 * MiB, WS_GB = 208 * MiB;
constexpr size_t WS_Y2 = 144 * MiB;
constexpr size_t WS_P = 272 * MiB;
constexpr size_t WS_X1 = 272 * MiB;
constexpr size_t WS_HID = 416 * MiB;
constexpr size_t WS_MGP = 416 * MiB;
constexpr int MGP = 1088;
constexpr size_t WS_DUMMY = 500 * MiB;
constexpr size_t WS_END = 501 * MiB;
constexpr int CW_CNT = 64;
constexpr int CW_BAR = 4096;
constexpr int CW_NRM = 3072;
constexpr int CW_QH = 3500;

constexpr int RING_OFF = 0, RING_BYTES = 131072;
constexpr int X_OFF = 147456;
constexpr int MOE_CNT_OFF = X_OFF, MOE_PB_OFF = X_OFF + 128, MOE_TOK_OFF = X_OFF + 512;
constexpr int P5_PE_OFF = X_OFF + 512, P5_PW_OFF = P5_PE_OFF + 1024, P5_LC_OFF = P5_PW_OFF + 1024, P5_GB_OFF = P5_LC_OFF + 128, P5_LG_OFF = P5_GB_OFF + 128, P5_FA_OFF = P5_LG_OFF + 5120, P5_FB_OFF = P5_FA_OFF + 4096;
constexpr int MISC_OFF = 163840 - 128;
constexpr int LDS_BYTES = 163840;
static_assert(P5_FB_OFF + 4096 <= MISC_OFF && MOE_TOK_OFF + 15 * 1024 <= MISC_OFF, "LDS map");

typedef unsigned short bf16;
typedef unsigned v4u __attribute__((ext_vector_type(4)));
typedef unsigned v2u __attribute__((ext_vector_type(2)));
typedef float f32x4 __attribute__((ext_vector_type(4)));
typedef GAS unsigned gu32;
#define RLX_AGENT __ATOMIC_RELAXED, __HIP_MEMORY_SCOPE_AGENT
#define LDS_WAIT() asm volatile("s_waitcnt lgkmcnt(0)" ::: "memory")
#define VM_WAIT() asm volatile("s_waitcnt vmcnt(0)" ::: "memory")
__device__ __forceinline__ unsigned f2bf(float f) { unsigned u = __builtin_bit_cast(unsigned, f); return (u + 0x7fffu + ((u >> 16) & 1u)) >> 16; }
__device__ __forceinline__ unsigned pk2(float lo, float hi) { return f2bf(lo) | (f2bf(hi) << 16); }
__device__ __forceinline__ float bflo(unsigned w) { return __builtin_bit_cast(float, w << 16); }
__device__ __forceinline__ float bfhi(unsigned w) { return __builtin_bit_cast(float, w & 0xffff0000u); }
__device__ __forceinline__ float fast_exp2(float x) { return __builtin_amdgcn_exp2f(x); }
__device__ __forceinline__ float fast_rcp(float x) { return __builtin_amdgcn_rcpf(x); }
__device__ __forceinline__ float sigmoidf_fast(float z) { return fast_rcp(1.f + fast_exp2(-z * LOG2E)); }
typedef float f32x2v __attribute__((ext_vector_type(2)));
__device__ __forceinline__ float dpp_f(float x, int ctrl) {
    switch (ctrl) {
    case 0xB1:  return __builtin_bit_cast(float, __builtin_amdgcn_update_dpp(0, __builtin_bit_cast(int, x), 0xB1, 0xF, 0xF, true));
    case 0x4E:  return __builtin_bit_cast(float, __builtin_amdgcn_update_dpp(0, __builtin_bit_cast(int, x), 0x4E, 0xF, 0xF, true));
    case 0x141: return __builtin_bit_cast(float, __builtin_amdgcn_update_dpp(0, __builtin_bit_cast(int, x), 0x141, 0xF, 0xF, true));
    default:    return __builtin_bit_cast(float, __builtin_amdgcn_update_dpp(0, __builtin_bit_cast(int, x), 0x140, 0xF, 0xF, true));
    }
}
__device__ __forceinline__ float wave_sum(float v) {
    v += dpp_f(v, 0xB1); v += dpp_f(v, 0x4E); v += dpp_f(v, 0x141); v += dpp_f(v, 0x140);
    { auto rr = __builtin_amdgcn_permlane16_swap(__float_as_uint(v), __float_as_uint(v), false, false); v = __uint_as_float(rr[0]) + __uint_as_float(rr[1]); }
    { auto rr = __builtin_amdgcn_permlane32_swap(__float_as_uint(v), __float_as_uint(v), false, false); v = __uint_as_float(rr[0]) + __uint_as_float(rr[1]); }
    return v;
}

namespace pg8 {
#define PG8_LAS __attribute__((address_space(3)))
typedef unsigned short bf16_t;
typedef short bf16x8 __attribute__((ext_vector_type(8)));
typedef float f32x4 __attribute__((ext_vector_type(4)));
typedef unsigned u32x4 __attribute__((ext_vector_type(4)));
constexpr int BM = 256, BK = 64, HALF = 128, HTB = HALF * BK * 2, STAGE_BYTES = 8 * HTB, NXCD = 8, WGM = 8;

__host__ __device__ __forceinline__ int lds_byte(int r, int c) { const int st = (r >> 4) * 2 + (c >> 5), rr = r & 15, cc = c & 31, ob = rr * 64 + cc * 2; return st * 1024 + (ob ^ (((ob >> 9) & 1) << 5)); }
__host__ __device__ __forceinline__ void stage_rc(int b, int& R, int& C) { const int st = b / 1024, sb = b % 1024, swz = sb ^ (((sb >> 9) & 1) << 5); R = (st >> 1) * 16 + swz / 64; C = (st & 1) * 32 + (swz % 64) / 2; }
__host__ __device__ __forceinline__ int perm32(int rho) { const int n = rho >> 4, i = rho & 15; return 8 * (i >> 2) + 4 * n + (i & 3); }

struct Unit { int pm, pn, e, seg, li, kind; };

struct StaticOrder {
    int nM, nN, nwg, G, c;
    __host__ __device__ void init(int M_, int N_, int G_, int c_) { nM = M_ / BM; nN = N_ / BM; nwg = nM * nN; G = G_; c = c_; }
    __host__ __device__ bool next(int i, Unit& u) const {
        const long L = (long)i * G + c; if (L >= nwg) return false;
        int wgid = (int)L; { const int q = nwg / NXCD, r = nwg % NXCD, xcd = wgid % NXCD, off = wgid / NXCD; wgid = (xcd < r ? xcd * (q + 1) : r * (q + 1) + (xcd - r) * q) + off; }
        const int nig = WGM * nN, gid = wgid / nig, fm = gid * WGM, gsz = (nM - fm) < WGM ? (nM - fm) : WGM;
        u.pm = fm + ((wgid % nig) % gsz); u.pn = (wgid % nig) / gsz; u.e = 0; u.seg = 0; u.li = i; u.kind = 0; return true;
    }
};
struct SegOrder {
    StaticOrder base;
    __device__ bool next(int i, Unit& u) const { if (!base.next(i >> 1, u)) return false; u.seg = i & 1; u.li = i; return true; }
};
struct MoeOrder {
    const PG8_LAS int* pbase; int nNsh, G, c;
    __device__ bool next(int i, Unit& u) const {
        const int x = c & 7, W = G >> 3; const int L = i * W + (c >> 3);
        int np[4], cp = 0;
#pragma unroll
        for (int k = 0; k < 4; ++k) { np[k] = __builtin_amdgcn_readfirstlane(pbase[x + 8 * k + 1]) - __builtin_amdgcn_readfirstlane(pbase[x + 8 * k]); cp += np[k]; }
        if (L >= (cp << nNsh)) return false;
        int lp = L >> nNsh; u.pn = L & ((1 << nNsh) - 1);
        int k = 0; if (lp >= np[0]) { lp -= np[0]; k = 1; if (lp >= np[1]) { lp -= np[1]; k = 2; if (lp >= np[2]) { lp -= np[2]; k = 3; } } }
        u.e = x + 8 * k; u.seg = lp; u.pm = __builtin_amdgcn_readfirstlane(pbase[u.e]) + lp; u.li = i; u.kind = 0; return true;
    }
};

struct SrcPlain { const char* A; const char* B; unsigned lda2; int K;
    __device__ __forceinline__ void a_off(const Unit& u, const int (&R)[2], const int (&C)[2], unsigned (&o)[2][2]) const {
#pragma unroll
        for (int h = 0; h < 2; ++h)
#pragma unroll
            for (int i = 0; i < 2; ++i) o[h][i] = (unsigned)(u.pm * BM + h * HALF + R[i]) * lda2 + (unsigned)C[i] * 2u; }
    __device__ __forceinline__ const char* b_ptr(const Unit& u) const { return B + (size_t)u.pn * BM * K * 2; }
};
struct SrcSeg { const char* A; const char* B0; const char* B1; unsigned lda2; unsigned acol0, acol1; int K;
    __device__ __forceinline__ void a_off(const Unit& u, const int (&R)[2], const int (&C)[2], unsigned (&o)[2][2]) const {
        const unsigned cb = u.seg ? acol1 : acol0;
#pragma unroll
        for (int h = 0; h < 2; ++h)
#pragma unroll
            for (int i = 0; i < 2; ++i) o[h][i] = (unsigned)(u.pm * BM + h * HALF + R[i]) * lda2 + cb + (unsigned)C[i] * 2u; }
    __device__ __forceinline__ const char* b_ptr(const Unit& u) const { return (u.seg ? B1 : B0) + (size_t)u.pn * BM * K * 2; }
};
struct SrcMoe1 { const char* A; const char* B; const PG8_LAS int* tokL; int K;
    __device__ __forceinline__ void a_off(const Unit& u, const int (&R)[2], const int (&C)[2], unsigned (&o)[2][2]) const {
#pragma unroll
        for (int h = 0; h < 2; ++h)
#pragma unroll
            for (int i = 0; i < 2; ++i) { const int tk = tokL[(u.li < 15 ? u.li : 14) * 256 + h * HALF + R[i]]; o[h][i] = (unsigned)(tk >> 1) * 2048u + (unsigned)C[i] * 2u; } }
    __device__ __forceinline__ const char* b_ptr(const Unit& u) const { return B + ((size_t)u.e * 512 + (size_t)u.pn * BM) * 1024 * 2; }
};
struct SrcMoe2 { const char* A; const char* B; int K;
    __device__ __forceinline__ void a_off(const Unit& u, const int (&R)[2], const int (&C)[2], unsigned (&o)[2][2]) const {
#pragma unroll
        for (int h = 0; h < 2; ++h)
#pragma unroll
            for (int i = 0; i < 2; ++i) o[h][i] = (unsigned)(u.pm * BM + h * HALF + R[i]) * 512u + (unsigned)C[i] * 2u; }
    __device__ __forceinline__ const char* b_ptr(const Unit& u) const { return B + ((size_t)u.e * 1024 + (size_t)u.pn * BM) * 256 * 2; }
};

__device__ __forceinline__ unsigned cvt_pk_bf16(float lo, float hi) { unsigned r; asm volatile("v_cvt_pk_bf16_f32 %0, %1, %2" : "=v"(r) : "v"(lo), "v"(hi)); return r; }

template <class Epi, class Sched, class Src, bool ALIGN_EPI>
__device__ __forceinline__ void gemm_phase(PG8_LAS unsigned char* lds, const Src& src, const Sched& S, const Epi& E) {
    int tid_ = threadIdx.x; asm volatile("" : "+v"(tid_));
    const int tid = tid_, wid = __builtin_amdgcn_readfirstlane(tid >> 6), lane = tid & 63, wr = wid >> 2, wc = wid & 3, fr = lane & 15, fq = lane >> 4;
    const int K = src.K, nt = K / BK;
    int Rr[2], Cc[2]; unsigned voffB[2];
#pragma unroll
    for (int i = 0; i < 2; ++i) { int R, C; stage_rc(tid * 16 + i * 8192, R, C); const int Rb = Epi::PERM ? ((R & ~31) + perm32(R & 31)) : R; Rr[i] = R; Cc[i] = C; voffB[i] = (unsigned)(Rb * K + C) * 2u; }
    const unsigned kstep = (unsigned)(BK * 2);
    const size_t hstepB = (size_t)HALF * K * 2;
    const unsigned ldsw = (unsigned)wid * 1024u;
    const int aoff = lds_byte(wr * 64 + fr, fq * 8), boff = lds_byte(wc * 32 + fr, fq * 8);
    const char* const Ab = src.A;
#define PG8_SA(b, h) (((b) * 2 + (h)) * HTB)
#define PG8_SB(b, h) ((4 + (b) * 2 + (h)) * HTB)
#define PG8_STAGE_B(bufoff, gbase) do { _Pragma("unroll") for (int _i = 0; _i < 2; ++_i) \
        __builtin_amdgcn_global_load_lds((const unsigned*)((const char*)(gbase) + voffB[_i]), (PG8_LAS unsigned*)(lds + (bufoff) + ldsw + _i * 8192), 16, 0, 0); } while (0)
#define PG8_STAGE_A(bufoff, h, OFFS, kb) do { _Pragma("unroll") for (int _i = 0; _i < 2; ++_i) \
        __builtin_amdgcn_global_load_lds((const unsigned*)(Ab + (size_t)((OFFS)[h][_i] + (kb))), (PG8_LAS unsigned*)(lds + (bufoff) + ldsw + _i * 8192), 16, 0, 0); } while (0)
#define PG8_LDA(dst, b, h) do { _Pragma("unroll") for (int m = 0; m < 4; ++m) _Pragma("unroll") for (int k = 0; k < 2; ++k) dst[m][k] = *(const PG8_LAS bf16x8*)(lds + PG8_SA(b, h) + aoff + m * 2048 + k * 1024); } while (0)
#define PG8_LDB(dst, b, h) do { _Pragma("unroll") for (int n = 0; n < 2; ++n) _Pragma("unroll") for (int k = 0; k < 2; ++k) dst[n][k] = *(const PG8_LAS bf16x8*)(lds + PG8_SB(b, h) + boff + n * 2048 + k * 1024); } while (0)
#define PG8_MMA(ai, bj, At, Bt) do { __builtin_amdgcn_s_setprio(1); _Pragma("unroll") for (int m = 0; m < 4; ++m) _Pragma("unroll") for (int n = 0; n < 2; ++n) _Pragma("unroll") for (int k = 0; k < 2; ++k) \
        acc[ai][bj][m][n] = __builtin_amdgcn_mfma_f32_16x16x32_bf16(Bt[n][k], At[m][k], acc[ai][bj][m][n], 0, 0, 0); __builtin_amdgcn_s_setprio(0); } while (0)
#define PG8_WAIT_V(n) asm volatile("s_waitcnt vmcnt(" #n ")" ::: "memory")
#define PG8_WAIT_L(n) asm volatile("s_waitcnt lgkmcnt(" #n ")" ::: "memory")
#define PG8_BAR __builtin_amdgcn_s_barrier()
#define PG8_SCHED __builtin_amdgcn_sched_barrier(0)
    Unit cur, nxt; int ui = 0;
    if (!S.next(0, cur)) return;
    f32x4 acc[2][2][4][2];
#pragma unroll
    for (int a = 0; a < 2; ++a)
#pragma unroll
        for (int b = 0; b < 2; ++b)
#pragma unroll
            for (int m = 0; m < 4; ++m)
#pragma unroll
                for (int n = 0; n < 2; ++n) acc[a][b][m][n] = (f32x4){0.f, 0.f, 0.f, 0.f};
    bf16x8 At[4][2], B0[2][2], B1[2][2];
    unsigned ao[2][2], no[2][2];
    src.a_off(cur, Rr, Cc, ao);
    const char* cB = src.b_ptr(cur);
    PG8_STAGE_B(PG8_SB(0, 0), cB); PG8_STAGE_B(PG8_SB(0, 1), cB + hstepB); PG8_STAGE_A(PG8_SA(0, 0), 0, ao, 0u); PG8_STAGE_A(PG8_SA(0, 1), 1, ao, 0u);
    if (wr == 1) PG8_BAR;
    PG8_WAIT_V(2); PG8_BAR;
    PG8_STAGE_B(PG8_SB(1, 0), cB + kstep); PG8_STAGE_A(PG8_SA(1, 0), 0, ao, kstep); PG8_STAGE_B(PG8_SB(1, 1), cB + hstepB + kstep);
    PG8_WAIT_V(6); PG8_BAR;
    for (;;) {
        const bool has_next = S.next(ui + 1, nxt);
        const char* nB = cB;
        if (has_next) { src.a_off(nxt, Rr, Cc, no); nB = src.b_ptr(nxt); }
        else {
#pragma unroll
            for (int h = 0; h < 2; ++h)
#pragma unroll
                for (int i = 0; i < 2; ++i) no[h][i] = ao[h][i]; }
        for (int t = 0; t < nt; t += 2) {
            const bool last = (t == nt - 2);
            const unsigned k1 = (unsigned)(t + 1) * kstep;
            const unsigned k2 = last ? 0u : (unsigned)(t + 2) * kstep, k3 = k2 + kstep;
            unsigned a2[2][2];
#pragma unroll
            for (int h = 0; h < 2; ++h)
#pragma unroll
                for (int i = 0; i < 2; ++i) a2[h][i] = last ? no[h][i] : ao[h][i];
            const char* b2 = last ? nB : cB + (size_t)k2; const char* b3 = b2 + kstep;
            PG8_LDB(B0, 0, 0); PG8_LDB(B1, 0, 1); PG8_SCHED; PG8_LDA(At, 0, 0); PG8_STAGE_A(PG8_SA(1, 1), 1, ao, k1);
            PG8_WAIT_V(8); PG8_WAIT_L(0); PG8_BAR; PG8_MMA(0, 0, At, B0); PG8_MMA(0, 1, At, B1); PG8_BAR; PG8_SCHED;
            PG8_LDA(At, 0, 1); PG8_STAGE_B(PG8_SB(0, 0), b2); PG8_STAGE_B(PG8_SB(0, 1), b2 + hstepB); PG8_STAGE_A(PG8_SA(0, 0), 0, a2, k2);
            PG8_WAIT_V(8); PG8_WAIT_L(0); PG8_BAR; PG8_MMA(1, 0, At, B0); PG8_MMA(1, 1, At, B1); PG8_BAR; PG8_SCHED;
            PG8_LDB(B0, 1, 0); PG8_LDB(B1, 1, 1); PG8_SCHED; PG8_LDA(At, 1, 0); PG8_STAGE_A(PG8_SA(0, 1), 1, a2, k2);
            PG8_WAIT_V(8); PG8_WAIT_L(0); PG8_BAR; PG8_MMA(0, 0, At, B0); PG8_MMA(0, 1, At, B1); PG8_BAR; PG8_SCHED;
            PG8_LDA(At, 1, 1); PG8_STAGE_B(PG8_SB(1, 0), b3); PG8_STAGE_B(PG8_SB(1, 1), b3 + hstepB); PG8_STAGE_A(PG8_SA(1, 0), 0, a2, k3);
            PG8_WAIT_V(8); PG8_WAIT_L(0); PG8_BAR; PG8_MMA(1, 0, At, B0); PG8_MMA(1, 1, At, B1); PG8_BAR; PG8_SCHED;
        }
        if constexpr (ALIGN_EPI) { if (wr == 0) PG8_BAR; }
        int fr_ = fr, fq_ = fq; asm volatile("" : "+v"(fr_), "+v"(fq_));
        const bool keep = E(acc, cur, wr, wc, fr_, fq_);
        if (!has_next) break;
        if (!keep) {
#pragma unroll
            for (int a = 0; a < 2; ++a)
#pragma unroll
                for (int b = 0; b < 2; ++b)
#pragma unroll
                    for (int m = 0; m < 4; ++m)
#pragma unroll
                        for (int n = 0; n < 2; ++n) acc[a][b][m][n] = (f32x4){0.f, 0.f, 0.f, 0.f};
        }
        cur = nxt; cB = nB; ++ui;
#pragma unroll
        for (int h = 0; h < 2; ++h)
#pragma unroll
            for (int i = 0; i < 2; ++i) ao[h][i] = no[h][i];
        if constexpr (ALIGN_EPI) { if (wr == 1) PG8_BAR; }
    }
    PG8_WAIT_V(0);
    if constexpr (!ALIGN_EPI) { if (wr == 0) PG8_BAR; }
    PG8_BAR;
#undef PG8_SA
#undef PG8_SB
#undef PG8_STAGE_A
#undef PG8_STAGE_B
#undef PG8_LDA
#undef PG8_LDB
#undef PG8_MMA
#undef PG8_WAIT_V
#undef PG8_WAIT_L
#undef PG8_BAR
#undef PG8_SCHED
}

struct EpiProj {
    static constexpr bool PERM = true;
    bf16_t* P; bf16_t* R; bf16_t* GB; unsigned* NRM;
    __device__ __forceinline__ bool operator()(f32x4 (&acc)[2][2][4][2], const Unit& u, int wr, int wc, int fr, int fq) const {
        const int row0 = u.pm * BM + wr * 64 + fr;
        if (u.pn < 9) {
            const float sc = (u.pn < 2 || u.pn == 3 || u.pn == 4) ? C2 : 1.f;
            const int col0 = u.pn * BM + wc * 32 + 8 * fq;
            if (u.pn >= 3 && u.pn <= 6) {
                float mx[2] = {0.f, 0.f};
#pragma unroll
                for (int ai = 0; ai < 2; ++ai)
#pragma unroll
                    for (int m = 0; m < 4; ++m)
#pragma unroll
                        for (int bj = 0; bj < 2; ++bj) { const f32x4 a = acc[ai][bj][m][0] * sc, c = acc[ai][bj][m][1] * sc;
                            float ss = (a[0] * a[0] + a[1] * a[1]) + (a[2] * a[2] + a[3] * a[3]) + (c[0] * c[0] + c[1] * c[1]) + (c[2] * c[2] + c[3] * c[3]);
                            ss += __shfl_xor(ss, 16); ss += __shfl_xor(ss, 32); mx[bj] = fmaxf(mx[bj], ss); }
#pragma unroll
                for (int bj = 0; bj < 2; ++bj) { float m_ = mx[bj];
#pragma unroll
                    for (int o = 1; o < 16; o <<= 1) m_ = fmaxf(m_, __shfl_xor(m_, o));
                    if ((threadIdx.x & 63) == 0) { const int isk = (u.pn >= 5) ? 1 : 0, head = (u.pn - (isk ? 5 : 3)) * 4 + 2 * bj + (wc >> 1);
                        atomicMax(NRM + ((u.pm >> 4) * 8 + head) * 4 + isk * 2 + (wc & 1), __float_as_uint(m_)); } }
            }
#pragma unroll
            for (int ai = 0; ai < 2; ++ai)
#pragma unroll
                for (int m = 0; m < 4; ++m) { bf16_t* rowp = P + (size_t)(row0 + ai * HALF + m * 16) * PP + col0;
#pragma unroll
                    for (int bj = 0; bj < 2; ++bj) { const f32x4 v0 = acc[ai][bj][m][0] * sc, v1 = acc[ai][bj][m][1] * sc;
                        u32x4 w; w.x = cvt_pk_bf16(v0[0], v0[1]); w.y = cvt_pk_bf16(v0[2], v0[3]); w.z = cvt_pk_bf16(v1[0], v1[1]); w.w = cvt_pk_bf16(v1[2], v1[3]);
                        *(u32x4*)(rowp + bj * HALF) = w; } }
        } else {
            const int col0 = (u.pn - 9) * 128 + wc * 32 + 8 * fq;
#pragma unroll
            for (int ai = 0; ai < 2; ++ai)
#pragma unroll
                for (int m = 0; m < 4; ++m) { const size_t off = (size_t)(row0 + ai * HALF + m * 16) * 1024 + col0;
                    float r[8], g[8];
#pragma unroll
                    for (int n = 0; n < 2; ++n)
#pragma unroll
                        for (int j = 0; j < 4; ++j) { const float ea = fast_exp2(-acc[ai][0][m][n][j] * LOG2E), eb = fast_exp2(-acc[ai][1][m][n][j] * LOG2E);
                            const float gb = fast_rcp(1.f + eb); g[n * 4 + j] = gb; r[n * 4 + j] = (1.f + eb) * fast_rcp(1.f + ea); }
                    u32x4 wr_, wg_;
                    wr_.x = cvt_pk_bf16(r[0], r[1]); wr_.y = cvt_pk_bf16(r[2], r[3]); wr_.z = cvt_pk_bf16(r[4], r[5]); wr_.w = cvt_pk_bf16(r[6], r[7]);
                    wg_.x = cvt_pk_bf16(g[0], g[1]); wg_.y = cvt_pk_bf16(g[2], g[3]); wg_.z = cvt_pk_bf16(g[4], g[5]); wg_.w = cvt_pk_bf16(g[6], g[7]);
                    *(u32x4*)(R + off) = wr_; *(u32x4*)(GB + off) = wg_; }
        }
        return false;
    }
};
struct EpiMerge {
    static constexpr bool PERM = true;
    const bf16_t* R; const bf16_t* GB; bf16_t* MG;
    __device__ __forceinline__ bool operator()(f32x4 (&acc)[2][2][4][2], const Unit& u, int wr, int wc, int fr, int fq) const {
        const int row0 = u.pm * BM + wr * 64 + fr, col0 = u.pn * BM + wc * 32 + 8 * fq;
        const bf16_t* S = u.seg ? GB : R;
        u32x4 sv[2][4][2];
#pragma unroll
        for (int ai = 0; ai < 2; ++ai)
#pragma unroll
            for (int m = 0; m < 4; ++m)
#pragma unroll
                for (int bj = 0; bj < 2; ++bj) sv[ai][m][bj] = *(const u32x4*)(S + (size_t)(row0 + ai * HALF + m * 16) * 1024 + col0 + bj * HALF);
#pragma unroll
        for (int ai = 0; ai < 2; ++ai)
#pragma unroll
            for (int m = 0; m < 4; ++m) { const size_t off = (size_t)(row0 + ai * HALF + m * 16) * MGP + col0;
#pragma unroll
                for (int bj = 0; bj < 2; ++bj) { const u32x4 s = sv[ai][m][bj];
                    f32x4 f0 = {bflo(s.x), bfhi(s.x), bflo(s.y), bfhi(s.y)}, f1 = {bflo(s.z), bfhi(s.z), bflo(s.w), bfhi(s.w)};
                    acc[ai][bj][m][0] = acc[ai][bj][m][0] * f0; acc[ai][bj][m][1] = acc[ai][bj][m][1] * f1;
                    if (u.seg) { const f32x4 v0 = acc[ai][bj][m][0], v1 = acc[ai][bj][m][1]; u32x4 w; w.x = cvt_pk_bf16(v0[0], v0[1]); w.y = cvt_pk_bf16(v0[2], v0[3]); w.z = cvt_pk_bf16(v1[0], v1[1]); w.w = cvt_pk_bf16(v1[2], v1[3]);
                        *(u32x4*)(MG + off + bj * HALF) = w; } } }
        return u.seg == 0;
    }
};
struct EpiResid {
    static constexpr bool PERM = true;
    const float* X; const float* MOD; bf16_t* X1;
    __device__ __forceinline__ bool operator()(f32x4 (&acc)[2][2][4][2], const Unit& u, int wr, int wc, int fr, int fq) const {
        const int row0 = u.pm * BM + wr * 64 + fr, col0 = u.pn * BM + wc * 32 + 8 * fq;
        const float* gm = MOD + (size_t)(u.pm >> 4) * 6144 + 2048 + col0;
        f32x4 g4[2][2];
#pragma unroll
        for (int bj = 0; bj < 2; ++bj)
#pragma unroll
            for (int n = 0; n < 2; ++n) g4[bj][n] = *(const f32x4*)(gm + bj * HALF + n * 4);
#pragma unroll
        for (int ai = 0; ai < 2; ++ai)
#pragma unroll
            for (int m = 0; m < 4; ++m) { const size_t off = (size_t)(row0 + ai * HALF + m * 16) * 1024 + col0;
#pragma unroll
                for (int bj = 0; bj < 2; ++bj) { const f32x4 x0 = *(const f32x4*)(X + off + bj * HALF), x1v = *(const f32x4*)(X + off + bj * HALF + 4);
                    const f32x4 v0 = x0 + g4[bj][0] * acc[ai][bj][m][0], v1 = x1v + g4[bj][1] * acc[ai][bj][m][1];
                    u32x4 w; w.x = cvt_pk_bf16(v0[0], v0[1]); w.y = cvt_pk_bf16(v0[2], v0[3]); w.z = cvt_pk_bf16(v1[0], v1[1]); w.w = cvt_pk_bf16(v1[2], v1[3]);
                    *(u32x4*)(X1 + off + bj * HALF) = w; } }
        return false;
    }
};
struct EpiHid {
    static constexpr bool PERM = true;
    const float* WL; const PG8_LAS int* cnt; bf16_t* HID;
    __device__ __forceinline__ bool operator()(f32x4 (&acc)[2][2][4][2], const Unit& u, int wr, int wc, int fr, int fq) const {
        const int n_e = cnt[u.e]; const int col0 = u.pn * 128 + wc * 32 + 8 * fq;
        float wv[2][4];
#pragma unroll
        for (int ai = 0; ai < 2; ++ai)
#pragma unroll
            for (int m = 0; m < 4; ++m) { const int slot = u.seg * 256 + ai * HALF + wr * 64 + m * 16 + fr; wv[ai][m] = (slot < n_e) ? WL[(size_t)u.e * LCAP + slot] : 0.f; }
#pragma unroll
        for (int ai = 0; ai < 2; ++ai)
#pragma unroll
            for (int m = 0; m < 4; ++m) { const int rl = ai * HALF + wr * 64 + m * 16 + fr; const int slot = u.seg * 256 + rl;
                if (slot < n_e) { const float w = wv[ai][m]; float h[8];
#pragma unroll
                    for (int n = 0; n < 2; ++n)
#pragma unroll
                        for (int j = 0; j < 4; ++j) { const float g = acc[ai][0][m][n][j], up = acc[ai][1][m][n][j]; h[n * 4 + j] = g * fast_rcp(1.f + fast_exp2(-g * LOG2E)) * up * w; }
                    u32x4 o; o.x = cvt_pk_bf16(h[0], h[1]); o.y = cvt_pk_bf16(h[2], h[3]); o.z = cvt_pk_bf16(h[4], h[5]); o.w = cvt_pk_bf16(h[6], h[7]);
                    *(u32x4*)(HID + ((size_t)u.pm * 256 + rl) * 256 + col0) = o; } }
        return false;
    }
};
struct EpiY {
    static constexpr bool PERM = true;
    const int* TOKL; const PG8_LAS int* cnt; bf16_t* Y2;
    __device__ __forceinline__ bool operator()(f32x4 (&acc)[2][2][4][2], const Unit& u, int wr, int wc, int fr, int fq) const {
        const int n_e = cnt[u.e]; const int col0 = u.pn * BM + wc * 32 + 8 * fq;
        int tkv[2][4];
#pragma unroll
        for (int ai = 0; ai < 2; ++ai)
#pragma unroll
            for (int m = 0; m < 4; ++m) { const int slot = u.seg * 256 + ai * HALF + wr * 64 + m * 16 + fr; tkv[ai][m] = (slot < n_e) ? TOKL[(size_t)u.e * LCAP + slot] : 0; }
#pragma unroll
        for (int ai = 0; ai < 2; ++ai)
#pragma unroll
            for (int m = 0; m < 4; ++m) { const int rl = ai * HALF + wr * 64 + m * 16 + fr; const int slot = u.seg * 256 + rl;
                if (slot < n_e) { const int tk = tkv[ai][m]; bf16_t* rowp = Y2 + (size_t)tk * 1024 + col0;
#pragma unroll
                    for (int bj = 0; bj < 2; ++bj) { const f32x4 v0 = acc[ai][bj][m][0], v1 = acc[ai][bj][m][1]; u32x4 w; w.x = cvt_pk_bf16(v0[0], v0[1]); w.y = cvt_pk_bf16(v0[2], v0[3]); w.z = cvt_pk_bf16(v1[0], v1[1]); w.w = cvt_pk_bf16(v1[2], v1[3]);
                        *(u32x4*)(rowp + bj * HALF) = w; } } }
        return false;
    }
};

}

namespace attn_body {
using bf16 = __hip_bfloat16;
using bf16x8 = __attribute__((ext_vector_type(8))) short;
using s16x4 = __attribute__((ext_vector_type(4))) short;
using f32x16 = __attribute__((ext_vector_type(16))) float;
using u32x4 = __attribute__((ext_vector_type(4))) unsigned;
constexpr int DH = 64, DM = PP;
constexpr int NW = 8, QBLK = 32, QB = QBLK * NW, KVBLK = 64;
__device__ __forceinline__ int crow(int r, int hi) { return (r & 3) + 8 * (r >> 2) + 4 * hi; }
#define SBAR() __builtin_amdgcn_sched_barrier(0)
__device__ __forceinline__ void cmask(f32x16& p0, f32x16& p1, int jb, int qrel, int hi) {
    const float NEG = -INFINITY; int kb = 64 * jb + 4 * hi;
#pragma unroll
    for (int r = 0; r < 16; ++r) { int kv = kb + (r & 3) + 8 * (r >> 2); if (kv > qrel) p0[r] = NEG; if (kv + 32 > qrel) p1[r] = NEG; }
}
constexpr int NSLOT = 3, SLOTB = 8192;
constexpr int LDS_K = 0, LDS_V = NSLOT * SLOTB, LDS_WS = 2 * NSLOT * SLOTB, LDS_TBL = LDS_WS + NW * 64 * 4  , LDS_OST = LDS_TBL + 8192, LDS_ATT = LDS_OST + NW * 4096;
constexpr int LDS_CUM = 94208;
constexpr int LDS_BYTES_ATT = LDS_CUM + 16384;
__device__ __forceinline__ void glds16(const void* gsrc, unsigned lds_dst) { unsigned keep;
    asm volatile("s_mov_b32 %0, m0\n\ts_mov_b32 m0, %2\n\ts_nop 0\n\tglobal_load_lds_dwordx4 %1, off\n\ts_mov_b32 m0, %0" : "=&s"(keep) : "v"(gsrc), "s"(lds_dst) : "memory"); }
__device__ __forceinline__ float max3f(float a, float b, float c) { float r; asm("v_max3_f32 %0, %1, %2, %3" : "=v"(r) : "v"(a), "v"(b), "v"(c)); return r; }
__device__ __forceinline__ float max2f(float a, float b) { float r; asm("v_max_f32_e32 %0, %1, %2" : "=v"(r) : "v"(a), "v"(b)); return r; }
__device__ __forceinline__ float fadd_s(float a, float b) { float r; asm("v_add_f32_e32 %0, %1, %2" : "=v"(r) : "v"(a), "v"(b)); return r; }
__device__ __forceinline__ float fsub_s(float a, float b) { float r; asm("v_sub_f32_e32 %0, %1, %2" : "=v"(r) : "v"(a), "v"(b)); return r; }
typedef float f32x2_t __attribute__((ext_vector_type(2))); typedef __bf16 bf16x2_t __attribute__((ext_vector_type(2)));
__device__ __forceinline__ unsigned cvtpk_s(float lo, float hi) { f32x2_t v = {lo, hi}; bf16x2_t b = __builtin_convertvector(v, bf16x2_t); return __builtin_bit_cast(unsigned, b); }
#define WAIT_BAR(N) asm volatile("s_waitcnt vmcnt(" #N ") lgkmcnt(0)\n\ts_barrier" ::: "memory")

typedef __attribute__((address_space(3))) const char* lds_cptr;
typedef __attribute__((address_space(3))) const float* lds_fptr;
typedef short v4i16_t __attribute__((ext_vector_type(4)));
typedef float f32x4_t __attribute__((ext_vector_type(4)));
__device__ __forceinline__ void kload8(bf16x8* kf, lds_cptr kp) {
    kf[0] = *(const __attribute__((address_space(3))) bf16x8*)(kp);        kf[1] = *(const __attribute__((address_space(3))) bf16x8*)(kp + 512);
    kf[2] = *(const __attribute__((address_space(3))) bf16x8*)(kp + 2048); kf[3] = *(const __attribute__((address_space(3))) bf16x8*)(kp + 2560);
    kf[4] = *(const __attribute__((address_space(3))) bf16x8*)(kp + 4096); kf[5] = *(const __attribute__((address_space(3))) bf16x8*)(kp + 4608);
    kf[6] = *(const __attribute__((address_space(3))) bf16x8*)(kp + 6144); kf[7] = *(const __attribute__((address_space(3))) bf16x8*)(kp + 6656);
}
__device__ __forceinline__ void kload2(bf16x8* kf, lds_cptr kp, int j) { kf[2 * j] = *(const __attribute__((address_space(3))) bf16x8*)(kp + j * 2048); kf[2 * j + 1] = *(const __attribute__((address_space(3))) bf16x8*)(kp + j * 2048 + 512); }
__device__ __forceinline__ s16x4 vtr(lds_cptr p) { return __builtin_bit_cast(s16x4, __builtin_amdgcn_ds_read_tr16_b64_v4i16((__attribute__((address_space(3))) v4i16_t*)p)); }
__device__ __forceinline__ float rowmax(const f32x16& p0, const f32x16& p1) {
    float a = max3f(p0[0], p0[1], p1[0]), b = max3f(p0[2], p0[3], p1[1]); a = max3f(a, p1[2], p1[3]);
#pragma unroll
    for (int r = 4; r < 16; r += 4) { a = max3f(a, p0[r], p0[r + 1]); b = max3f(b, p0[r + 2], p0[r + 3]); a = max3f(a, p1[r], p1[r + 1]); b = max3f(b, p1[r + 2], p1[r + 3]); }
    const float m = max2f(a, b);
    auto rr = __builtin_amdgcn_permlane32_swap(__float_as_uint(m), __float_as_uint(m), false, false);
    return max2f(__uint_as_float(rr[0]), __uint_as_float(rr[1]));
}
__device__ __forceinline__ void pv(f32x16* o, int vb, bf16x8 pa0, bf16x8 pa1, bf16x8 pa2, bf16x8 pa3) {
#pragma unroll
    for (int d0 = 0; d0 < 2; ++d0) { s16x4 lo[4], hi[4];
#pragma unroll
        for (int ks = 0; ks < 4; ++ks) {
            asm volatile("ds_read_b64_tr_b16 %0,%1 offset:%c2" : "=&v"(lo[ks]) : "v"(vb), "i"(d0 * 4096 + ks * 1024) : "memory");
            asm volatile("ds_read_b64_tr_b16 %0,%1 offset:%c2" : "=&v"(hi[ks]) : "v"(vb), "i"(d0 * 4096 + ks * 1024 + 512) : "memory"); }
        asm volatile("s_waitcnt lgkmcnt(0)" ::: "memory"); SBAR();
#define PK(k) (bf16x8){lo[k][0], lo[k][1], lo[k][2], lo[k][3], hi[k][0], hi[k][1], hi[k][2], hi[k][3]}
        o[d0] = __builtin_amdgcn_mfma_f32_32x32x16_bf16(pa0, PK(0), o[d0], 0, 0, 0);
        o[d0] = __builtin_amdgcn_mfma_f32_32x32x16_bf16(pa1, PK(1), o[d0], 0, 0, 0);
        o[d0] = __builtin_amdgcn_mfma_f32_32x32x16_bf16(pa2, PK(2), o[d0], 0, 0, 0);
        o[d0] = __builtin_amdgcn_mfma_f32_32x32x16_bf16(pa3, PK(3), o[d0], 0, 0, 0);
#undef PK
    }
}

#define ATTN_STORE16(p, v) (*(u32x4*)(p) = (v))
template <int MODE, int THRL> __device__ __forceinline__ void attn_unit(int b, int hq, int qb, bf16* P, const float* __restrict__ aux, float sink2, char* shm, bool do_store, float thr, unsigned* qhead, volatile __attribute__((address_space(3))) int* qslot) {
    int tid_ = threadIdx.x; asm volatile("" : "+v"(tid_));
    const int tid = tid_, lane = tid & 63, r32 = lane & 31, hi = lane >> 5; const int wid = __builtin_amdgcn_readfirstlane(tid >> 6);
    const int hw = (MODE == 1) ? hq + (wid >> 2) : hq, wrow = (MODE == 1) ? (wid & 3) * QBLK : wid * QBLK;
    const long rowbase = (long)b * SEQ; const int q0 = (MODE == 1) ? qb * 128 : qb * QB;
    int k0;
    if (MODE == 1) k0 = (q0 >= 128 ? q0 - 128 : 0);
    else {
        const float* cg = aux + (long)(b * 8 + hq) * SEQ; const int NT0 = (q0 + QB) / KVBLK;
        const float cq0 = cg[q0]; const float ckT = (lane < NT0) ? cg[64 * lane + 63] : 0.f;
        const unsigned long long keep = __ballot((lane < NT0) && (cq0 - ckT > thr));
        int tf = keep ? (int)__builtin_ctzll(keep) : NT0; tf &= ~1; if (tf > NT0 - 4) tf = NT0 - 4;
        k0 = 64 * __builtin_amdgcn_readfirstlane(tf);
    }
    const int qcol = (MODE == 1) ? C_QA + hw * 64 : C_QB + hq * 64;
    const int kcol = (MODE == 1) ? C_KA + (hq >> 2) * 64 : C_KB + hq * 64;
    const int vcol = (MODE == 1) ? C_VA + (hq >> 2) * 64 : C_VB + hq * 64;
    const bf16* Qw = P + (rowbase + q0 + wrow) * DM + qcol;
    const bf16* Kh = P + (rowbase + k0) * DM + kcol, *Vh = P + (rowbase + k0) * DM + vcol;
    const unsigned lds0 = (unsigned)(uintptr_t)shm;
    float* wsf = (float*)(shm + LDS_WS) + wid * 64;
    const lds_cptr shm3 = (lds_cptr)shm;
    const lds_fptr cumL = (lds_fptr)(shm3 + (MODE == 0 ? LDS_CUM : LDS_TBL + (wid >> 2) * 4096));
    if (MODE == 0) { const float* src = aux + (long)(b * 8 + hq) * SEQ; for (int i = tid * 4; i < q0 + QB; i += 2048) *(f32x4_t*)((float*)(shm + LDS_CUM) + i) = *(const f32x4_t*)(src + i); }
    else { const float* src = aux + hq * 1024;
#pragma unroll
        for (int i = 0; i < 4; ++i) ((float*)(shm + LDS_TBL))[tid + 512 * i] = src[tid + 512 * i]; }
    const bf16* ksrc = Kh + (long)lane * DM + wid * 8;
    const bf16* vsrc = Vh + (long)(16 * (wid & 3) + (lane >> 2)) * DM + (wid >> 2) * 32 + (lane & 3) * 8;
    const unsigned kdst = lds0 + LDS_K + wid * 1024, vdst = lds0 + LDS_V + wid * 1024;
#define DMA_K(t, slot) glds16(ksrc + (long)(t) * KVBLK * DM, (unsigned)__builtin_amdgcn_readfirstlane(kdst + (slot)))
#define DMA_V(t, slot) glds16(vsrc + (long)(t) * KVBLK * DM, (unsigned)__builtin_amdgcn_readfirstlane(vdst + (slot)))
    const int vb0 = (int)(lds0 + LDS_V) + ((lane >> 4) & 1) * 32 + (lane & 3) * 8 + (4 * hi + ((lane & 15) >> 2)) * 64;
    bf16x8 kf[8];
    const lds_cptr kp0 = shm3 + LDS_K + hi * 1024 + r32 * 16; const lds_cptr vp0 = shm3 + LDS_V + ((lane >> 4) & 1) * 32 + (lane & 3) * 8 + (4 * hi + ((lane & 15) >> 2)) * 64;
    const int NT = (MODE == 1) ? 4 : (q0 + QB - k0) / KVBLK;
    DMA_K(0, 0); DMA_V(0, 0); DMA_K(1, SLOTB);
    bf16x8 qr[4];
#pragma unroll
    for (int d0 = 0; d0 < 4; ++d0) qr[d0] = *reinterpret_cast<const bf16x8*>(&Qw[(long)r32 * DM + d0 * 16 + hi * 8]);
    float mhat = 0.f, negq = 0.f, l_reg = 0.f; f32x16 o[2]; o[0] = f32x16{}; o[1] = f32x16{};
    const int qrel = wrow + r32;
    const int qk0 = q0 + qrel - k0;
#define CINIT(C0, C1, t) do { if (MODE == 0) { const lds_fptr ck_ = cumL + (k0 + 64 * (t) + 4 * hi); \
        _Pragma("unroll") for (int j_ = 0; j_ < 4; ++j_) { const f32x4_t a_ = *(const __attribute__((address_space(3))) f32x4_t*)(ck_ + 8 * j_), b_ = *(const __attribute__((address_space(3))) f32x4_t*)(ck_ + 32 + 8 * j_); \
            _Pragma("unroll") for (int i_ = 0; i_ < 4; ++i_) { C0[4 * j_ + i_] = negq - a_[i_]; C1[4 * j_ + i_] = negq - b_[i_]; } } } \
      else { const lds_fptr tb_ = cumL + (qk0 - 64 * (t) - 4 * hi + 256); \
        _Pragma("unroll") for (int r_ = 0; r_ < 16; ++r_) { const int kv_ = (r_ & 3) + 8 * (r_ >> 2); C0[r_] = negq + tb_[-kv_]; C1[r_] = negq + tb_[-kv_ - 32]; } } } while (0)
#define CMASK(P0, P1, t) do { if (MODE == 0) { int jb_ = (t) - (NT - 4); if (jb_ >= 0) cmask(P0, P1, jb_, qrel, hi); } \
      } while (0)
    bool resc = false;
#define START(P0, P1) do { const float rm = rowmax(P0, P1); resc = false; \
    { const float dl = (rm < -1e30f) ? 0.f : rm; mhat = fadd_s(mhat, dl); negq = fsub_s(negq, dl); \
      _Pragma("unroll") for (int r = 0; r < 16; ++r) { P0[r] = fsub_s(P0[r], dl); P1[r] = fsub_s(P1[r], dl); } } \
    _Pragma("unroll") for (int r = 0; r < 16; ++r) P0[r] = __builtin_amdgcn_exp2f(P0[r]); } while (0)
#define RESC() do { if (resc) { asm volatile("s_waitcnt lgkmcnt(0)" ::: "memory"); \
      _Pragma("unroll") for (int d_ = 0; d_ < 2; ++d_) _Pragma("unroll") for (int r = 0; r < 16; ++r) o[d_][r] *= wsf[crow(r, hi)]; } } while (0)
    f32x16 pA0, pA1, pB0, pB1;
    int sl_prev = 0, sl_cur = 0, sl_next = SLOTB;
#define ROT() do { sl_prev = sl_cur; sl_cur = sl_next; sl_next = (sl_next == (NSLOT - 1) * SLOTB) ? 0 : sl_next + SLOTB; } while (0)
    DMA_K(2, 2 * SLOTB);
    WAIT_BAR(3);
    if (MODE == 0) negq = cumL[q0 + qrel];
    { CINIT(pA0, pA1, 0);
      const char* kb = shm + LDS_K + hi * 1024 + r32 * 16;
#pragma unroll
      for (int d0 = 0; d0 < 4; ++d0) {
          const bf16x8 b0 = *reinterpret_cast<const bf16x8*>(kb + d0 * 2048);
          const bf16x8 b1 = *reinterpret_cast<const bf16x8*>(kb + d0 * 2048 + 512);
          pA0 = __builtin_amdgcn_mfma_f32_32x32x16_bf16(b0, qr[d0], pA0, 0, 0, 0); pA1 = __builtin_amdgcn_mfma_f32_32x32x16_bf16(b1, qr[d0], pA1, 0, 0, 0); } }
    asm volatile("s_nop 15\n\ts_nop 7" : "+v"(pA0), "+v"(pA1)); CMASK(pA0, pA1, 0);
    asm volatile("s_nop 7" : "+v"(pA0), "+v"(pA1));
    START(pA0, pA1);
#pragma unroll
    for (int r = 0; r < 16; ++r) pA1[r] = __builtin_amdgcn_exp2f(pA1[r]);
    WAIT_BAR(0);
    DMA_K(3, 0); DMA_V(1, SLOTB);
    ROT();
    kload8(kf, kp0 + sl_cur);
    WAIT_BAR(2);
    s16x4 vlo[8], vhi[8]; u32x4 pw0, pw1, pw2, pw3;
#define PKW(P, B) cvtpk_s(P[B], P[B + 1])
#define PAF(k) __builtin_bit_cast(bf16x8, pw##k)
#define VFR(i) (bf16x8){vlo[i][0], vlo[i][1], vlo[i][2], vlo[i][3], vhi[i][0], vhi[i][1], vhi[i][2], vhi[i][3]}
#define PIN(x) asm volatile("" : "+v"(x))
#define MX3(a, b, c) __builtin_fmaxf(__builtin_fmaxf((a), (b)), (c))
#define GAPA(MF, A0, A1, A2, A3, W0, W1, PW) do { MF; sacc += A0; sacc += A1; sacc += A2; sacc += A3; PIN(sacc); W0; W1; PIN(PW); SBAR(); } while (0)
#define EX(v) __builtin_amdgcn_exp2f(v)
#define GAPB(MF, X, B) do { MF; X[B] = EX(X[B]); X[B + 1] = EX(X[B + 1]); X[B + 2] = EX(X[B + 2]); X[B + 3] = EX(X[B + 3]); PIN(X); SBAR(); } while (0)
#define VRD(i) do { vlo[i] = vtr(vp_ + (((i) >> 2) * 4096 + ((i) & 3) * 1024)); vhi[i] = vtr(vp_ + (((i) >> 2) * 4096 + ((i) & 3) * 1024 + 512)); } while (0)
#define KRD(G, j) do { if (G) { kload2(kf, kp0 + sl_next, j); SBAR(); } } while (0)
#define STEP(C0, C1, P0, P1, t, GK, GV, GL) do { SBAR(); \
    const lds_cptr vp_ = vp0 + sl_prev; \
    CINIT(C0, C1, t); SBAR(); \
    VRD(0); SBAR(); float sacc = (P0[0] + P0[1]); \
    GAPA(C0 = __builtin_amdgcn_mfma_f32_32x32x16_bf16(kf[0], qr[0], C0, 0, 0, 0), P0[2], P0[3], P0[4], P0[5],     pw0[0] = PKW(P0, 0), pw0[1] = PKW(P0, 2), pw0); \
    VRD(4); SBAR(); GAPA(C1 = __builtin_amdgcn_mfma_f32_32x32x16_bf16(kf[1], qr[0], C1, 0, 0, 0), P0[6], P0[7], P0[8], P0[9],     pw0[2] = PKW(P0, 4), pw0[3] = PKW(P0, 6), pw0); \
    VRD(1); SBAR(); GAPA(C0 = __builtin_amdgcn_mfma_f32_32x32x16_bf16(kf[2], qr[1], C0, 0, 0, 0),   P0[10], P0[11], P0[12], P0[13], pw1[0] = PKW(P0, 8), pw1[1] = PKW(P0, 10), pw1); \
    VRD(5); SBAR(); GAPA(C1 = __builtin_amdgcn_mfma_f32_32x32x16_bf16(kf[3], qr[1], C1, 0, 0, 0),   P0[14], P0[15], P1[0], P1[1],   pw1[2] = PKW(P0, 12), pw1[3] = PKW(P0, 14), pw1); \
    VRD(2); SBAR(); GAPA(C0 = __builtin_amdgcn_mfma_f32_32x32x16_bf16(kf[4], qr[2], C0, 0, 0, 0),   P1[2], P1[3], P1[4], P1[5],     pw2[0] = PKW(P1, 0), pw2[1] = PKW(P1, 2), pw2); \
    VRD(6); SBAR(); GAPA(C1 = __builtin_amdgcn_mfma_f32_32x32x16_bf16(kf[5], qr[2], C1, 0, 0, 0),   P1[6], P1[7], P1[8], P1[9],     pw2[2] = PKW(P1, 4), pw2[3] = PKW(P1, 6), pw2); \
    VRD(3); SBAR(); GAPA(C0 = __builtin_amdgcn_mfma_f32_32x32x16_bf16(kf[6], qr[3], C0, 0, 0, 0),   P1[10], P1[11], P1[12], P1[13], pw3[0] = PKW(P1, 8), pw3[1] = PKW(P1, 10), pw3); \
    VRD(7); SBAR(); GAPA(C1 = __builtin_amdgcn_mfma_f32_32x32x16_bf16(kf[7], qr[3], C1, 0, 0, 0),   P1[14], P1[15], 0.f, 0.f,       pw3[2] = PKW(P1, 12), pw3[3] = PKW(P1, 14), pw3); \
    l_reg += sacc; \
    if (GK) { DMA_K((t) + 3, sl_cur); } if (GV) { DMA_V((t) + 1, sl_next); } \
    CMASK(C0, C1, t); \
    { float a = MX3(C0[0], C0[1], C1[0]), b = MX3(C0[2], C0[3], C1[1]); a = MX3(a, C1[2], C1[3]); \
      _Pragma("unroll") for (int r = 4; r < 16; r += 4) { a = MX3(a, C0[r], C0[r + 1]); b = MX3(b, C0[r + 2], C0[r + 3]); a = MX3(a, C1[r], C1[r + 1]); b = MX3(b, C1[r + 2], C1[r + 3]); } \
      float rm = __builtin_fmaxf(a, b); { auto rr = __builtin_amdgcn_permlane32_swap(__float_as_uint(rm), __float_as_uint(rm), false, false); rm = __builtin_fmaxf(__uint_as_float(rr[0]), __uint_as_float(rr[1])); } \
      resc = false; \
      if (__builtin_expect(__any(rm > (float)THRL), 0)) { const float dl = __builtin_fmaxf(rm, 0.f); mhat += dl; negq -= dl; \
        _Pragma("unroll") for (int r = 0; r < 16; ++r) { C0[r] -= dl; C1[r] -= dl; } \
        const float f = __builtin_amdgcn_exp2f(-dl); l_reg *= f; if (hi == 0) wsf[r32] = f; resc = true; } } \
    SBAR(); \
    GAPB(o[0] = __builtin_amdgcn_mfma_f32_32x32x16_bf16(PAF(0), VFR(0), o[0], 0, 0, 0), C0, 0); \
    GAPB(o[1] = __builtin_amdgcn_mfma_f32_32x32x16_bf16(PAF(0), VFR(4), o[1], 0, 0, 0), C0, 4); \
    KRD(GL, 0); GAPB(o[0] = __builtin_amdgcn_mfma_f32_32x32x16_bf16(PAF(1), VFR(1), o[0], 0, 0, 0), C0, 8); \
    KRD(GL, 1); GAPB(o[1] = __builtin_amdgcn_mfma_f32_32x32x16_bf16(PAF(1), VFR(5), o[1], 0, 0, 0), C0, 12); \
    KRD(GL, 2); GAPB(o[0] = __builtin_amdgcn_mfma_f32_32x32x16_bf16(PAF(2), VFR(2), o[0], 0, 0, 0), C1, 0); \
    KRD(GL, 3); GAPB(o[1] = __builtin_amdgcn_mfma_f32_32x32x16_bf16(PAF(2), VFR(6), o[1], 0, 0, 0), C1, 4); \
    GAPB(o[0] = __builtin_amdgcn_mfma_f32_32x32x16_bf16(PAF(3), VFR(3), o[0], 0, 0, 0), C1, 8); \
    GAPB(o[1] = __builtin_amdgcn_mfma_f32_32x32x16_bf16(PAF(3), VFR(7), o[1], 0, 0, 0), C1, 12); \
    } while (0)
    int t = 1;
    if (MODE == 0) {
        for (; t + 5 < NT; t += 2) {
            STEP(pB0, pB1, pA0, pA1, t, true, true, true);     WAIT_BAR(2); RESC(); ROT();
            STEP(pA0, pA1, pB0, pB1, t + 1, true, true, true); WAIT_BAR(2); RESC(); ROT();
        }
    }
#define ENDW(tt) do { if ((tt) + 3 < NT) { WAIT_BAR(2); } else if ((tt) + 2 < NT) { WAIT_BAR(1); } else { WAIT_BAR(0); } } while (0)
    for (; t + 1 < NT; t += 2) {
        STEP(pB0, pB1, pA0, pA1, t, (t + 3 < NT), (t + 1 < NT), (t + 1 < NT));         ENDW(t);     RESC(); ROT();
        STEP(pA0, pA1, pB0, pB1, t + 1, (t + 4 < NT), (t + 2 < NT), (t + 2 < NT));     ENDW(t + 1); RESC(); ROT();
    }
    STEP(pB0, pB1, pA0, pA1, NT - 1, false, false, false); RESC();
    { float sacc = pB0[0] + pB0[1];
#pragma unroll
      for (int r = 2; r < 16; ++r) sacc += pB0[r];
#pragma unroll
      for (int r = 0; r < 16; ++r) sacc += pB1[r];
      l_reg += sacc;
      pw0 = (u32x4){PKW(pB0, 0), PKW(pB0, 2), PKW(pB0, 4), PKW(pB0, 6)}; pw1 = (u32x4){PKW(pB0, 8), PKW(pB0, 10), PKW(pB0, 12), PKW(pB0, 14)}; pw2 = (u32x4){PKW(pB1, 0), PKW(pB1, 2), PKW(pB1, 4), PKW(pB1, 6)}; pw3 = (u32x4){PKW(pB1, 8), PKW(pB1, 10), PKW(pB1, 12), PKW(pB1, 14)};
      SBAR(); pv(o, vb0 + sl_cur, PAF(0), PAF(1), PAF(2), PAF(3)); }
#undef PKW
#undef PAF
#undef VFR
#undef PIN
#undef MX3
#undef GAPA
#undef GAPB
#undef EX
#undef VRD
#undef KRD
#undef STEP
#undef ENDW
    int nxt_ = 0; if (tid == 0) nxt_ = (int)__hip_atomic_fetch_add(qhead, 1u, __ATOMIC_RELAXED, __HIP_MEMORY_SCOPE_AGENT);
    { auto rr = __builtin_amdgcn_permlane32_swap(__float_as_uint(l_reg), __float_as_uint(l_reg), false, false); l_reg = __uint_as_float(rr[0]) + __uint_as_float(rr[1]); }
    if (MODE == 1) l_reg += __builtin_amdgcn_exp2f(aux[8192 + hw] - mhat);
    if (hi == 0) wsf[32 + r32] = l_reg; asm volatile("s_waitcnt lgkmcnt(0)" ::: "memory");
    float rli[16];
#pragma unroll
    for (int r = 0; r < 16; ++r) rli[r] = __builtin_amdgcn_rcpf(wsf[32 + crow(r, hi)]);
    bf16* Ow = P + (rowbase + q0 + wrow) * DM + qcol;
    { bf16* stg = (bf16*)(shm + LDS_OST) + wid * 2048;
#pragma unroll
      for (int r = 0; r < 16; ++r) { const int orow = crow(r, hi);
#pragma unroll
          for (int d0 = 0; d0 < 2; ++d0) stg[orow * 64 + d0 * 32 + r32] = __float2bfloat16(o[d0][r] * rli[r]); }
      asm volatile("s_waitcnt lgkmcnt(0)" ::: "memory");
#pragma unroll
      for (int i = 0; i < 4; ++i) { const int row = i * 8 + (lane >> 3), ch = lane & 7; const u32x4 v = *(const u32x4*)(stg + row * 64 + ch * 8); if (do_store) ATTN_STORE16(Ow + (long)row * DM + ch * 8, v); } }
    if (tid == 0) qslot[0] = nxt_;
    asm volatile("s_waitcnt lgkmcnt(0)\n\ts_barrier" ::: "memory");
#undef DMA_K
#undef DMA_V
#undef CMASK
#undef CINIT
#undef START
#undef RESC
#undef ROT
}
#undef SBAR
#undef WAIT_BAR
}


namespace down_body {
using bf16x8 = __attribute__((ext_vector_type(8))) short;
using f32x16 = __attribute__((ext_vector_type(16))) float;
using u32x4 = __attribute__((ext_vector_type(4))) unsigned;
__device__ __forceinline__ void glds16(const void* gsrc, unsigned lds_dst) { unsigned keep;
    asm volatile("s_mov_b32 %0, m0\n\ts_mov_b32 m0, %2\n\ts_nop 0\n\tglobal_load_lds_dwordx4 %1, off\n\ts_mov_b32 m0, %0" : "=&s"(keep) : "v"(gsrc), "s"(lds_dst) : "memory"); }
typedef float f32x2_t __attribute__((ext_vector_type(2))); typedef __bf16 bf16x2_t __attribute__((ext_vector_type(2)));
__device__ __forceinline__ unsigned cvtpk(float lo, float hi) { f32x2_t v = {lo, hi}; bf16x2_t b = __builtin_convertvector(v, bf16x2_t); return __builtin_bit_cast(unsigned, b); }
__device__ __forceinline__ void glds4(const void* gsrc, unsigned lds_dst) { unsigned keep;
    asm volatile("s_mov_b32 %0, m0\n\ts_mov_b32 m0, %2\n\ts_nop 0\n\tglobal_load_lds_dword %1, off\n\ts_mov_b32 m0, %0" : "=&s"(keep) : "v"(gsrc), "s"(lds_dst) : "memory"); }
__device__ __forceinline__ void down_phase(char* shm, __attribute__((address_space(3))) int* tkL, const __attribute__((address_space(3))) int* cnt, const __attribute__((address_space(3))) int* pbase,
                                           const int G, const int bx, const unsigned short* HID, const unsigned short* WD, const int* TOKL, unsigned short* Y2, unsigned short* sink) {
    typedef __attribute__((address_space(3))) const char* lds_cptr;
    int tid_ = threadIdx.x; asm volatile("" : "+v"(tid_));
    const int tid = tid_, lane = tid & 63, r32 = lane & 31, hi = lane >> 5; const int wid = __builtin_amdgcn_readfirstlane(tid >> 6);
    const unsigned lds0 = (unsigned)(uintptr_t)shm, ldstk = (unsigned)(uintptr_t)tkL;
    const lds_cptr rdbase = (lds_cptr)shm + r32 * 512 + 16 * (hi ^ (r32 & 1));
    const int rm = r32 >> 1;
    const int drow0 = 2 * wid + hi, drow1 = drow0 + 16;
    const unsigned dsrc0 = drow0 * 256 + ((r32 ^ drow0) & 31) * 8, dsrc1 = drow1 * 256 + ((r32 ^ drow1) & 31) * 8;
    const int wcol = 16 * ((r32 >> 2) & 1) + (r32 & 3) + 4 * (r32 >> 3);
    const int x = bx & 7, W = G >> 3, rk = bx >> 3;
    int J = 0;
#pragma unroll
    for (int k = 0; k < 4; ++k) J += 4 * ((__builtin_amdgcn_readfirstlane(cnt[x + 8 * k]) + 31) >> 5);
    const int chunk = (J + W - 1) / W, j0 = rk * chunk, j1 = (j0 + chunk < J) ? j0 + chunk : J;
    int pos = 0;
#pragma unroll 1
    for (int kp = 0; kp < 16; ++kp) {
        const int e = x + 8 * (kp >> 2), pn = kp & 3; const int cn = __builtin_amdgcn_readfirstlane(cnt[e]); const int Tk = (cn + 31) >> 5;
        const int t0 = (j0 > pos ? j0 : pos) - pos, t1 = (j1 < pos + Tk ? j1 : pos + Tk) - pos; pos += Tk;
        if (t0 >= t1) continue;
        const int n = t1 - t0;
        const unsigned short* wrow = WD + ((size_t)e * 1024 + pn * 256 + 32 * wid + wcol) * 256 + hi * 8;
        bf16x8 wfr[16];
#pragma unroll
        for (int ks = 0; ks < 16; ++ks) wfr[ks] = *(const bf16x8*)(wrow + ks * 16);
        const unsigned short* hbase = HID + ((size_t)__builtin_amdgcn_readfirstlane(pbase[e]) * 256 + 32 * t0) * 256;
        const int* tsrc = TOKL + (size_t)e * LCAP + 32 * t0 + r32;
        unsigned short* ycol = Y2 + pn * 256 + 32 * wid + 16 * hi;
        const int rows_left = cn - 32 * t0 - r32;
#define DN_DMA(tl, buf) do { const int tc_ = (tl) < n ? (tl) : n - 1; const unsigned short* s_ = hbase + (size_t)tc_ * (32 * 256); \
        glds16(s_ + dsrc0, (unsigned)__builtin_amdgcn_readfirstlane(lds0 + (buf) * 16384 + wid * 1024)); \
        glds16(s_ + dsrc1, (unsigned)__builtin_amdgcn_readfirstlane(lds0 + (buf) * 16384 + (wid + 8) * 1024)); \
        glds4(tsrc + tc_ * 32, (unsigned)__builtin_amdgcn_readfirstlane(ldstk + (buf) * 256)); } while (0)
        DN_DMA(0, 0); DN_DMA(1, 1); DN_DMA(2, 2); DN_DMA(3, 3); DN_DMA(4, 4);
        asm volatile("s_waitcnt vmcnt(12) lgkmcnt(0)\n\ts_barrier" ::: "memory");
        bf16x8 hfA[8], hfB[8];
#pragma unroll
        for (int ks = 0; ks < 8; ++ks) hfA[ks] = *(const __attribute__((address_space(3))) bf16x8*)(rdbase + 32 * (ks ^ rm));
#pragma unroll 1
        for (int j = 0; j < n; ++j) { const int bo = (j & 7) * 16384, bn = ((j + 1) & 7) * 16384;
#pragma unroll
            for (int ks = 0; ks < 8; ++ks) hfB[ks] = *(const __attribute__((address_space(3))) bf16x8*)(rdbase + bo + 32 * ((ks + 8) ^ rm));
            const int tk = tkL[(j & 7) * 64 + r32];
            __builtin_amdgcn_sched_barrier(0);
            f32x16 acc = f32x16{};
#pragma unroll
            for (int ks = 0; ks < 8; ++ks) acc = __builtin_amdgcn_mfma_f32_32x32x16_bf16(wfr[ks], hfA[ks], acc, 0, 0, 0);
            __builtin_amdgcn_sched_barrier(0);
            if (j >= 4) asm volatile("s_waitcnt vmcnt(17)\n\ts_barrier" ::: "memory");
            else if (j == 0) asm volatile("s_waitcnt vmcnt(9)\n\ts_barrier" ::: "memory");
            else if (j == 1) asm volatile("s_waitcnt vmcnt(11)\n\ts_barrier" ::: "memory");
            else if (j == 2) asm volatile("s_waitcnt vmcnt(13)\n\ts_barrier" ::: "memory");
            else asm volatile("s_waitcnt vmcnt(15)\n\ts_barrier" ::: "memory");
#pragma unroll
            for (int ks = 0; ks < 8; ++ks) hfA[ks] = *(const __attribute__((address_space(3))) bf16x8*)(rdbase + bn + 32 * (ks ^ rm));
            __builtin_amdgcn_sched_barrier(0);
#pragma unroll
            for (int ks = 0; ks < 8; ++ks) acc = __builtin_amdgcn_mfma_f32_32x32x16_bf16(wfr[ks + 8], hfB[ks], acc, 0, 0, 0);
            __builtin_amdgcn_sched_barrier(0);
            DN_DMA(j + 5, (j + 5) & 7);
            unsigned short* orow = (32 * j < rows_left) ? ycol + (size_t)tk * 1024 : sink + 16 * hi;
            u32x4 o0, o1;
            o0.x = cvtpk(acc[0], acc[1]);  o0.y = cvtpk(acc[2], acc[3]);  o0.z = cvtpk(acc[4], acc[5]);  o0.w = cvtpk(acc[6], acc[7]);
            o1.x = cvtpk(acc[8], acc[9]);  o1.y = cvtpk(acc[10], acc[11]); o1.z = cvtpk(acc[12], acc[13]); o1.w = cvtpk(acc[14], acc[15]);
            *(u32x4*)orow = o0; *(u32x4*)(orow + 8) = o1;
        }
#undef DN_DMA
        asm volatile("s_waitcnt vmcnt(0) lgkmcnt(0)\n\ts_barrier" ::: "memory");
    }
}
}

#define XB_TMO      128
#define XB_XCNT(j)  (256  + 64 * (j))
#define XB_XSUB(j)  (1280 + 64 * (j))
#define XB_XGEN(j)  (2304 + 64 * (j))
#define XB_TOP      3328
#define XB_TOPGEN   3392
#define XCD_BAR_WORDS 3456
#define XB_SPIN_CAP (1u << 18)
__device__ __forceinline__ unsigned xb_ld(unsigned* p)              { return __hip_atomic_load(p, __ATOMIC_RELAXED, __HIP_MEMORY_SCOPE_AGENT); }
__device__ __forceinline__ unsigned xb_add(unsigned* p, unsigned v) { return __hip_atomic_fetch_add(p, v, __ATOMIC_RELAXED, __HIP_MEMORY_SCOPE_AGENT); }
__device__ __forceinline__ unsigned xb_xcc_id() { return (unsigned)__builtin_amdgcn_s_getreg((3 << 11) | 20) & 0xFu; }
#define XB_SPIN(cond, bar) do { unsigned _sp = 0; while (cond) { __builtin_amdgcn_s_sleep(1); \
    if ((++_sp & 255u) == 0u) { if (xb_ld(&(bar)[XB_TMO])) break; if (_sp > XB_SPIN_CAP) { atomicAdd(&(bar)[XB_TMO], 1u); break; } } } } while (0)
struct XcdBarrier { unsigned* bar; unsigned x; volatile LAS unsigned* st; };
__device__ __forceinline__ XcdBarrier xcd_barrier_post(unsigned* bar, volatile LAS unsigned* st) {
    XcdBarrier b; b.bar = bar; b.x = xb_xcc_id(); b.st = st;
    if (threadIdx.x == 0) (void)xb_add(&bar[XB_XCNT(b.x)], 1u);
    return b;
}
__device__ __forceinline__ void xcd_barrier_complete(unsigned* bar, unsigned x, unsigned& nloc, unsigned& nx) {
    const unsigned G = gridDim.x * gridDim.y * gridDim.z;
    unsigned sum, cnt, mine, sp = 0u;
    for (;;) {
        sum = 0u; cnt = 0u; mine = 0u;
#pragma unroll
        for (unsigned j = 0; j < 16; ++j) { const unsigned c = xb_ld(&bar[XB_XCNT(j)]); sum += c; cnt += (c > 0u) ? 1u : 0u; mine = (j == x) ? c : mine; }
        if (sum == G) break;
        __builtin_amdgcn_s_sleep(1);
        if ((++sp & 255u) == 0u) { if (xb_ld(&bar[XB_TMO])) break; if (sp > XB_SPIN_CAP) { atomicAdd(&bar[XB_TMO], 1u); break; } }
    }
    nloc = mine > 0u ? mine : 1u; nx = cnt > 0u ? cnt : 1u;
}
__device__ __forceinline__ void xcd_barrier(const XcdBarrier& b) {
    asm volatile("s_waitcnt vmcnt(0)" ::: "memory");
    __syncthreads();
    if (threadIdx.x == 0) {
        unsigned* bar = b.bar;
        __builtin_amdgcn_s_waitcnt(0);
        unsigned nloc = b.st[0], nx = b.st[1];
        if (nloc == 0u) { xcd_barrier_complete(bar, b.x, nloc, nx); b.st[0] = nloc; b.st[1] = nx; }
        const unsigned old = xb_add(&bar[XB_XSUB(b.x)], 1u);
        const unsigned gen = old / nloc;
        if (old + 1u == (gen + 1u) * nloc) {
            __builtin_amdgcn_fence(__ATOMIC_RELEASE, "agent");
            asm volatile("s_waitcnt vmcnt(0)" ::: "memory");
            const unsigned og = xb_add(&bar[XB_TOP], 1u);
            const unsigned tg = og / nx;
            if (og + 1u == (tg + 1u) * nx) xb_add(&bar[XB_TOPGEN], 1u);
            else XB_SPIN(xb_ld(&bar[XB_TOPGEN]) == tg, bar);
            __builtin_amdgcn_fence(__ATOMIC_ACQUIRE, "agent");
            xb_add(&bar[XB_XGEN(b.x)], 1u);
            asm volatile("s_waitcnt vmcnt(0)" ::: "memory");
        } else {
            XB_SPIN(xb_ld(&bar[XB_XGEN(b.x)]) == gen, bar);
            __builtin_amdgcn_fence(__ATOMIC_ACQUIRE, "agent");
            asm volatile("s_waitcnt vmcnt(0)" ::: "memory");
        }
    }
    __syncthreads();
}

struct Args {
    const float *x, *c, *w_ada, *b_ada, *g_mix, *g_ffn, *w_in, *sinks, *b_forget, *w_pa, *w_pb, *w_out, *rel, *w_rg, *b_rg, *w_re, *b_re, *w_g, *w_u, *w_d, *g_final;
    float* out; unsigned char* ws; int ph_lo, ph_hi;
};

__device__ __forceinline__ void transpose_item(const float* W, int ldw, int K, int k0, int srccol0, bf16* WT, int dstrow0, LAS float* scr, int lane) {
#pragma unroll 8
    for (int i = 0; i < 32; ++i) { const int kk = 2 * i + (lane >> 5); scr[kk * 33 + (lane & 31)] = W[(size_t)(k0 + kk) * ldw + srccol0 + (lane & 31)]; }
    LDS_WAIT(); asm volatile("" ::: "memory");
    const int c = lane & 7;
#pragma unroll
    for (int j = 0; j < 4; ++j) { const int n = (lane >> 3) + 8 * j; const LAS float* s = scr + (8 * c) * 33 + n;
        v4u o; o.x = pk2(s[0 * 33], s[1 * 33]); o.y = pk2(s[2 * 33], s[3 * 33]); o.z = pk2(s[4 * 33], s[5 * 33]); o.w = pk2(s[6 * 33], s[7 * 33]);
        *(GAS v4u*)(WT + (size_t)(dstrow0 + n) * K + k0 + 8 * c) = o; }
    LDS_WAIT(); asm volatile("" ::: "memory");
}

__device__ __forceinline__ int t5_bucket(int n) {
    if (n < 16) return n;
    int large = 16 + (int)(logf((float)n / 16.0f) / logf(8.0f) * 16.0f);
    return large < 31 ? large : 31;
}

__global__ void __launch_bounds__(NWAVES * 64, 2) fwd_kernel(Args args) {
    extern __shared__ __attribute__((aligned(16))) unsigned char lds[];
    LAS unsigned char* const L = (LAS unsigned char*)lds;
    volatile LAS unsigned* const MISC = (volatile LAS unsigned*)(L + MISC_OFF);
    const int tid = threadIdx.x, lane = tid & 63, wave = __builtin_amdgcn_readfirstlane(tid >> 6);
    const int G = gridDim.x, bx = blockIdx.x;
    const int vcu = (G % 8 == 0) ? (bx % 8) * (G / 8) + bx / 8 : bx;
    unsigned char* const ws = args.ws;
    unsigned* const ctl = (unsigned*)(ws + WS_CTL);
    float* const MOD = (float*)(ws + WS_MOD);
    float* const LOGF = (float*)(ws + WS_LOGF);
    float* const CUM = (float*)(ws + WS_CUM);
    float* const SWAT = (float*)(ws + WS_SWAT);
    int* const TOKL = (int*)(ws + WS_TOKL);
    float* const WLST = (float*)(ws + WS_WL);
    bf16* const WIN = (bf16*)(ws + WS_WIN); bf16* const WPA = (bf16*)(ws + WS_WPA); bf16* const WPB = (bf16*)(ws + WS_WPB); bf16* const WOUT = (bf16*)(ws + WS_WOUT);
    bf16* const WGU = (bf16*)(ws + WS_WGU); bf16* const WD = (bf16*)(ws + WS_WD);
    bf16* const HB = (bf16*)(ws + WS_H); bf16* const RB = (bf16*)(ws + WS_R); bf16* const GBB = (bf16*)(ws + WS_GB); bf16* const Y2 = (bf16*)(ws + WS_Y2);
    bf16* const PB = (bf16*)(ws + WS_P); bf16* const HID = (bf16*)(ws + WS_HID);
    bf16* const X1 = (bf16*)(ws + WS_X1);
    if (tid < 32) MISC[tid] = 0u;
    __syncthreads();
    XcdBarrier bar = xcd_barrier_post(ctl + CW_BAR, MISC + 8);
    const int lo = args.ph_lo, hi = args.ph_hi;
#define IN(k) (lo <= (k) && (k) < hi)
#define GRID_BAR(k) do { if (IN(k) && IN((k) + 1)) xcd_barrier(bar); } while (0)

    if (IN(0)) for (int rep_ = 0; rep_ < REPS(0); ++rep_) {
        if (rep_) __syncthreads();
        if (bx < 192) {
            LAS float* sc = (LAS float*)L; LAS float* red = (LAS float*)(L + 32768);
            for (int i = tid; i < 8192; i += 512) { const float v = args.c[i]; sc[i] = v / (1.f + expf(-v)); }
            __syncthreads();
            const int kg = tid >> 3, cq = tid & 7, col0 = 32 * bx;
            f32x4 a[8];
#pragma unroll
            for (int b = 0; b < 8; ++b) a[b] = (f32x4){0.f, 0.f, 0.f, 0.f};
            for (int k = kg; k < 1024; k += 64) { const f32x4 w4 = *(const f32x4*)(args.w_ada + (size_t)k * 6144 + col0 + 4 * cq);
#pragma unroll
                for (int b = 0; b < 8; ++b) a[b] += sc[b * 1024 + k] * w4; }
#pragma unroll
            for (int b = 0; b < 8; ++b)
#pragma unroll
                for (int j = 0; j < 4; ++j) red[(kg * 8 + b) * 32 + cq * 4 + j] = a[b][j];
            __syncthreads();
            if (tid < 256) { const int b = tid >> 5, j = tid & 31; float s = 0.f; for (int g = 0; g < 64; ++g) s += red[(g * 8 + b) * 32 + j]; MOD[b * 6144 + col0 + j] = s + args.b_ada[col0 + j]; }
            __syncthreads();
        } else if (bx < 208) {
            const int i = (bx - 192) * 512 + tid; const int h = i >> 10, d = (i & 1023) - 256;
            SWAT[i] = (d >= 0 && d < 128) ? args.rel[t5_bucket(d) * 8 + h] * LOG2E : -INFINITY;
            if (i < 8) SWAT[8192 + i] = args.sinks[i] * LOG2E;
        }
        LAS float* scr = (LAS float*)(L + wave * 16384);
        const int gw = bx * NWAVES + wave, NGW = G * NWAVES;
        constexpr int I_IN = 136 * 16, I_PA = 32 * 8, I_OUT = 32 * 16;
        constexpr int NITEMS = I_IN + 2 * I_PA + I_OUT;
        for (int it = gw; it < NITEMS; it += NGW) {
            int r = it;
            if (r < I_IN) { const int rb = r >> 4, kb = r & 15; const int d0 = rb * 32; int s0;
                if (d0 < 2304) s0 = d0; else { const int t = (d0 - 2304) >> 8, w = (d0 - 2304) & 255; s0 = (w < 128) ? 2312 + 128 * t + w : 2312 + 1024 + 128 * t + (w - 128); }
                transpose_item(args.w_in, IN_COLS, 1024, kb * 64, s0, WIN, d0, scr, lane); continue; } r -= I_IN;
            if (r < I_PA) { const int rb = r >> 3, kb = r & 7; transpose_item(args.w_pa, 1024, 512, kb * 64, rb * 32, WPA, rb * 32, scr, lane); continue; } r -= I_PA;
            if (r < I_PA) { const int rb = r >> 3, kb = r & 7; transpose_item(args.w_pb, 1024, 512, kb * 64, rb * 32, WPB, rb * 32, scr, lane); continue; } r -= I_PA;
            { const int rb = r >> 4, kb = r & 15; transpose_item(args.w_out, 1024, 1024, kb * 64, rb * 32, WOUT, rb * 32, scr, lane); }
        }
    }
    GRID_BAR(0);

    if (IN(1)) for (int rep_ = 0; rep_ < REPS(1); ++rep_) {
        __syncthreads();
        LAS float* wf = (LAS float*)L;
        for (int s = tid; s < 8192; s += 512) { const int c = s >> 3, j = s & 7; wf[j * 1024 + c] = args.w_in[(size_t)c * IN_COLS + 2304 + j]; }
        __syncthreads();
        const int gw = bx * NWAVES + wave; const int row0 = gw * 16, b = row0 >> 12;
        const float* shift = MOD + b * 6144, *scale = MOD + b * 6144 + 1024;
        f32x4 fa[4], fb[4];
#pragma unroll
        for (int j = 0; j < 4; ++j) { const int c = 4 * lane + 256 * j; const f32x4 g = *(const f32x4*)(args.g_mix + c), s = *(const f32x4*)(scale + c); fa[j] = g * (1.f + s); fb[j] = *(const f32x4*)(shift + c); }
        for (int rr = 0; rr < 16; ++rr) { const int row = row0 + rr;
            const f32x4* xr = (const f32x4*)(args.x + (size_t)row * D) + lane;
            f32x4 v[4]; float ss = 0.f;
#pragma unroll
            for (int j = 0; j < 4; ++j) { v[j] = __builtin_nontemporal_load(xr + 64 * j); ss += (v[j].x * v[j].x + v[j].y * v[j].y) + (v[j].z * v[j].z + v[j].w * v[j].w); }
            const float rstd = 1.0f / sqrtf(wave_sum(ss) * (1.f / D) + EPS);
#pragma unroll
            for (int j = 0; j < 4; ++j) v[j] = v[j] * rstd * fa[j] + fb[j];
            unsigned long long* o8 = (unsigned long long*)(HB + (size_t)row * D) + lane;
#pragma unroll
            for (int j = 0; j < 4; ++j) o8[64 * j] = (unsigned long long)pk2(v[j].x, v[j].y) | ((unsigned long long)pk2(v[j].z, v[j].w) << 32);
            float mine = 0.f;
#pragma unroll
            for (int o = 0; o < 8; ++o) { float p = 0.f;
#pragma unroll
                for (int j = 0; j < 4; ++j) { const f32x4 w4 = *(const LAS f32x4*)(wf + o * 1024 + 4 * lane + 256 * j); p += (v[j].x * w4.x + v[j].y * w4.y) + (v[j].z * w4.z + v[j].w * w4.w); }
                p = wave_sum(p); if (lane == o) mine = p; }
            if (lane < 8) { const float z = mine + args.b_forget[lane]; const float ls = fminf(z, 0.f) - log1pf(expf(-fabsf(z))); LOGF[(size_t)row * 8 + lane] = ls; }
        }
    }
    GRID_BAR(1);
    if ((PROBE_MASK >> 11) & 1) { xcd_barrier(bar); xcd_barrier(bar); xcd_barrier(bar); xcd_barrier(bar); }

    if (IN(2)) for (int rep_ = 0; rep_ < REPS(2); ++rep_) {
        if (bx < 64) {
            __syncthreads();
            LAS float* wsum = (LAS float*)L;
            const int b = bx >> 3, h = bx & 7; float v[8]; float run = 0.f;
#pragma unroll
            for (int i = 0; i < 8; ++i) { run += LOGF[((size_t)b * SEQ + tid * 8 + i) * 8 + h]; v[i] = run; }
            float s = run;
#pragma unroll
            for (int o = 1; o < 64; o <<= 1) { const float t = __shfl_up(s, o); if (lane >= o) s += t; }
            if (lane == 63) wsum[wave] = s;
            __syncthreads();
            float off = s - run; for (int w = 0; w < wave; ++w) off += wsum[w];
#pragma unroll
            for (int i = 0; i < 8; ++i) CUM[(size_t)bx * SEQ + tid * 8 + i] = (off + v[i]) * LOG2E;
            __syncthreads();
        }
        pg8::SrcPlain src{(const char*)HB, (const char*)WIN, 2048u, 1024};
        pg8::StaticOrder S; S.init(M, NPROJ, G, bx);
        pg8::EpiProj E{PB, RB, GBB, ctl + CW_NRM};
        pg8::gemm_phase<pg8::EpiProj, pg8::StaticOrder, pg8::SrcPlain, true>(L + RING_OFF, src, S, E);
        if (G == 256 ? bx >= 128 : true) {
            constexpr int I_GU = 32 * 16 * 16, I_D = 32 * 32 * 4;
            LAS float* scr = (LAS float*)(L + wave * 16384);
            const int w0 = (G == 256) ? (bx - 128) * NWAVES + wave : bx * NWAVES + wave, nw = (G == 256) ? 128 * NWAVES : G * NWAVES;
            for (int it = w0; it < I_GU + I_D; it += nw) {
                int r = it;
                if (r < I_GU) { const int e = r >> 8, q = r & 255, rb = q >> 4, kb = q & 15; const int d0 = rb * 32, pn = d0 >> 8, w = d0 & 255;
                    const float* src = (w < 128) ? args.w_g : args.w_u; const int s0 = 128 * pn + (w & 127);
                    transpose_item(src + (size_t)e * 1024 * 256, 256, 1024, kb * 64, s0, WGU + (size_t)e * 512 * 1024, d0, scr, lane); continue; } r -= I_GU;
                { const int e = r >> 7, q = r & 127, rb = q >> 2, kb = q & 3;
                  transpose_item(args.w_d + (size_t)e * 256 * 1024, 1024, 256, kb * 64, rb * 32, WD + (size_t)e * 1024 * 256, rb * 32, scr, lane); }
            }
        }
    }
    GRID_BAR(2);

    if (IN(3)) {
        if (G == 256) {
            const int xb = bx & 7; unsigned* const qh = ctl + CW_QH + xb * 32; volatile LAS int* const qslot = (volatile LAS int*)(L + MISC_OFF) + 16;
            if (tid == 0) qslot[0] = (int)__hip_atomic_fetch_add(qh, 1u, RLX_AGENT);
            __syncthreads();
            for (int rep_ = 0; rep_ < REPS(3); ++rep_)
            for (;;) { const int idx = __builtin_amdgcn_readfirstlane(qslot[0]); if (idx >= 128) break;
                const int hq = idx & 7, qb = 15 - (idx >> 3);
                const unsigned* nr = ctl + CW_NRM + (xb * 8 + hq) * 4;
                const float q2 = __uint_as_float(nr[0]) + __uint_as_float(nr[1]), k2 = __uint_as_float(nr[2]) + __uint_as_float(nr[3]);
                const float thr = -(80.f + 2.1f * sqrtf(q2 * k2));
                attn_body::attn_unit<0, 8>(xb, hq, qb, (attn_body::bf16*)PB, CUM, 0.f, (char*)lds + RING_OFF, true, thr, qh, qslot); }
            __syncthreads();
            if (tid == 0) qslot[0] = (int)__hip_atomic_fetch_add(qh + 16, 1u, RLX_AGENT);
            __syncthreads();
            for (int rep_ = 0; rep_ < REPS(10); ++rep_)
            for (;;) { const int idx = __builtin_amdgcn_readfirstlane(qslot[0]); if (idx >= 128) break;
                const int hq = (idx & 3) * 2, qb = idx >> 2;
                attn_body::attn_unit<1, 8>(xb, hq, qb, (attn_body::bf16*)PB, SWAT, 0.f, (char*)lds + RING_OFF, true, 0.f, qh + 16, qslot); }
        }
    }
    GRID_BAR(3);

    if (IN(4)) for (int rep_ = 0; rep_ < REPS(4); ++rep_) {
        pg8::SrcSeg src{(const char*)PB, (const char*)WPA, (const char*)WPB, (unsigned)(PP * 2), (unsigned)(C_QA * 2), (unsigned)(C_QB * 2), 512};
        pg8::SegOrder S; S.base.init(M, D, G, bx);
        pg8::EpiMerge E{RB, GBB, (bf16*)(ws + WS_MGP)};
        pg8::gemm_phase<pg8::EpiMerge, pg8::SegOrder, pg8::SrcSeg, true>(L + RING_OFF, src, S, E);
    }
    GRID_BAR(4);

    if (IN(5)) for (int rep_ = 0; rep_ < REPS(5); ++rep_) {
        pg8::SrcPlain src{(const char*)(ws + WS_MGP), (const char*)WOUT, (unsigned)(MGP * 2), 1024};
        pg8::StaticOrder S; S.init(M, D, G, bx);
        pg8::EpiResid E{args.x, MOD, X1};
        pg8::gemm_phase<pg8::EpiResid, pg8::StaticOrder, pg8::SrcPlain, true>(L + RING_OFF, src, S, E);
    }
    GRID_BAR(5);

    if (IN(6)) for (int rep_ = 0; rep_ < REPS(6); ++rep_) {
        __syncthreads();
        LAS float* Wr = (LAS float*)L;
        LAS int* peL = (LAS int*)(L + P5_PE_OFF); LAS float* pwL = (LAS float*)(L + P5_PW_OFF); LAS int* lcount = (LAS int*)(L + P5_LC_OFF); LAS int* gbase = (LAS int*)(L + P5_GB_OFF);
        LAS float* lgs = (LAS float*)(L + P5_LG_OFF) + wave * 160; LAS float* facA = (LAS float*)(L + P5_FA_OFF); LAS float* facB = (LAS float*)(L + P5_FB_OFF);
        const int b = (bx * 128) >> 12;
        for (int c = tid; c < 1024; c += 512) { const f32x4 w = *(const f32x4*)(args.w_rg + 4 * c); Wr[c] = w.x; Wr[1024 + c] = w.y; Wr[2048 + c] = w.z; Wr[3072 + c] = w.w; }
        for (int it = tid; it < 4096; it += 512) { const int g = it >> 10, c = it & 1023; const f32x4 wa = *(const f32x4*)(args.w_re + (size_t)it * 8), wb = *(const f32x4*)(args.w_re + (size_t)it * 8 + 4);
            LAS float* d = Wr + (4 + g * 8) * 1024 + c; d[0] = wa.x; d[1024] = wa.y; d[2048] = wa.z; d[3072] = wa.w; d[4096] = wb.x; d[5120] = wb.y; d[6144] = wb.z; d[7168] = wb.w; }
        for (int c = tid; c < 1024; c += 512) { facA[c] = args.g_ffn[c] * (1.f + MOD[b * 6144 + 4096 + c]); facB[c] = MOD[b * 6144 + 3072 + c]; }
        if (tid < 32) lcount[tid] = 0;
        __syncthreads();
        v2u raw[4][4];
#pragma unroll
        for (int r = 0; r < 4; ++r) { const v2u* xr = (const v2u*)(X1 + (size_t)(bx * 128 + wave * 16 + r) * D) + lane;
#pragma unroll
            for (int j = 0; j < 4; ++j) raw[r][j] = xr[64 * j]; }
        for (int grp = 0; grp < 4; ++grp) { const int lrow0 = wave * 16 + grp * 4; const int row0 = bx * 128 + lrow0;
            f32x4 v[4][4];
#pragma unroll
            for (int r = 0; r < 4; ++r)
#pragma unroll
                for (int j = 0; j < 4; ++j) { const v2u xw = raw[r][j]; v[r][j] = (f32x4){bflo(xw.x), bfhi(xw.x), bflo(xw.y), bfhi(xw.y)}; }
            if (grp < 3) {
#pragma unroll
                for (int r = 0; r < 4; ++r) { const v2u* xr = (const v2u*)(X1 + (size_t)(row0 + 4 + r) * D) + lane;
#pragma unroll
                    for (int j = 0; j < 4; ++j) raw[r][j] = xr[64 * j]; } }
#pragma unroll
            for (int r = 0; r < 4; ++r) { float ss = 0.f;
#pragma unroll
                for (int j = 0; j < 4; ++j) { ss += (v[r][j].x * v[r][j].x + v[r][j].y * v[r][j].y) + (v[r][j].z * v[r][j].z + v[r][j].w * v[r][j].w); }
                const float rstd = 1.0f / sqrtf(wave_sum(ss) * (1.f / D) + EPS);
                unsigned long long* o8 = (unsigned long long*)(HB + (size_t)(row0 + r) * D) + lane;
#pragma unroll
                for (int j = 0; j < 4; ++j) { const f32x4 fa = *(const LAS f32x4*)(facA + 4 * lane + 256 * j), fb = *(const LAS f32x4*)(facB + 4 * lane + 256 * j);
                    v[r][j] = v[r][j] * rstd * fa + fb; o8[64 * j] = (unsigned long long)pk2(v[r][j].x, v[r][j].y) | ((unsigned long long)pk2(v[r][j].z, v[r][j].w) << 32); } }
#define P5_DOT(ROWS, WPTR, OUT) do { f32x2v a2_[4]; \
                _Pragma("unroll") for (int r_ = 0; r_ < 4; ++r_) a2_[r_] = (f32x2v){0.f, 0.f}; \
                _Pragma("unroll") for (int j_ = 0; j_ < 4; ++j_) { const f32x4 w4_ = *(const LAS f32x4*)((WPTR) + 256 * j_); const f32x2v wl_ = {w4_.x, w4_.y}, wh_ = {w4_.z, w4_.w}; \
                    _Pragma("unroll") for (int r_ = 0; r_ < 4; ++r_) if ((ROWS) & (1 << r_)) { a2_[r_] += (f32x2v){v[r_][j_].x, v[r_][j_].y} * wl_; a2_[r_] += (f32x2v){v[r_][j_].z, v[r_][j_].w} * wh_; } } \
                _Pragma("unroll") for (int r_ = 0; r_ < 4; ++r_) OUT[r_] = a2_[r_].x + a2_[r_].y; } while (0)
#define P5_SWAP32(A, B) ({ auto rr_ = __builtin_amdgcn_permlane32_swap(__float_as_uint(A), __float_as_uint(B), false, false); __uint_as_float(rr_[0]) + __uint_as_float(rr_[1]); })
#define P5_SWAP16(A, B) ({ auto rr_ = __builtin_amdgcn_permlane16_swap(__float_as_uint(A), __float_as_uint(B), false, false); __uint_as_float(rr_[0]) + __uint_as_float(rr_[1]); })
#define P5_ROW16(Z) do { Z += dpp_f(Z, 0xB1); Z += dpp_f(Z, 0x4E); Z += dpp_f(Z, 0x141); Z += dpp_f(Z, 0x140); } while (0)
            const int q_ = lane >> 4, sub_ = (q_ == 1) ? 2 : (q_ == 2) ? 1 : q_;
            { float X[16];
#pragma unroll
                for (int g = 0; g < 4; ++g) { float o_[4]; P5_DOT(15, Wr + g * 1024 + 4 * lane, o_);
#pragma unroll
                    for (int r = 0; r < 4; ++r) X[r * 4 + g] = o_[r]; }
                float Y[8], Z[4];
#pragma unroll
                for (int m = 0; m < 8; ++m) Y[m] = P5_SWAP32(X[2 * m], X[2 * m + 1]);
#pragma unroll
                for (int n = 0; n < 4; ++n) { Z[n] = P5_SWAP16(Y[2 * n], Y[2 * n + 1]); P5_ROW16(Z[n]); }
                if ((lane & 15) == 0) {
#pragma unroll
                    for (int n = 0; n < 4; ++n) { const int i = 4 * n + sub_; lgs[(i >> 2) * 40 + (i & 3)] = Z[n]; } } }
            LDS_WAIT(); asm volatile("" ::: "memory");
            int gsel[4];
#pragma unroll
            for (int r = 0; r < 4; ++r) { float best = lgs[r * 40] + args.b_rg[0]; int gi_ = 0;
#pragma unroll
                for (int g = 1; g < 4; ++g) { const float z = lgs[r * 40 + g] + args.b_rg[g]; if (z > best) { best = z; gi_ = g; } }
                gsel[r] = __builtin_amdgcn_readfirstlane(gi_); }
            { float X[32];
#pragma unroll
                for (int r = 0; r < 4; ++r) { const LAS float* wbase = Wr + (4 + gsel[r] * 8) * 1024 + 4 * lane;
#pragma unroll
                    for (int e = 0; e < 8; ++e) { f32x2v a2_ = {0.f, 0.f};
#pragma unroll
                        for (int j = 0; j < 4; ++j) { const f32x4 w4_ = *(const LAS f32x4*)(wbase + e * 1024 + 256 * j);
                            a2_ += (f32x2v){v[r][j].x, v[r][j].y} * (f32x2v){w4_.x, w4_.y}; a2_ += (f32x2v){v[r][j].z, v[r][j].w} * (f32x2v){w4_.z, w4_.w}; }
                        X[r * 8 + e] = a2_.x + a2_.y; } }
                float Y[16], Z[8];
#pragma unroll
                for (int m = 0; m < 16; ++m) Y[m] = P5_SWAP32(X[2 * m], X[2 * m + 1]);
#pragma unroll
                for (int n = 0; n < 8; ++n) { Z[n] = P5_SWAP16(Y[2 * n], Y[2 * n + 1]); P5_ROW16(Z[n]); }
                if ((lane & 15) == 0) {
#pragma unroll
                    for (int n = 0; n < 8; ++n) { const int i = 4 * n + sub_; lgs[(i >> 3) * 40 + 4 + (i & 7)] = Z[n]; } } }
#undef P5_DOT
#undef P5_SWAP32
#undef P5_SWAP16
#undef P5_ROW16
            LDS_WAIT(); asm volatile("" ::: "memory");
            if (lane < 4) { const LAS float* lg = lgs + lane * 40;
                float gl[4]; int gi = 0; float gmax;
#pragma unroll
                for (int j = 0; j < 4; ++j) gl[j] = lg[j] + args.b_rg[j];
                gmax = gl[0];
#pragma unroll
                for (int j = 1; j < 4; ++j) if (gl[j] > gmax) { gmax = gl[j]; gi = j; }
                float den = 0.f;
#pragma unroll
                for (int j = 0; j < 4; ++j) den += expf(gl[j] - gmax);
                const float gp = 1.f / den;
                float v1 = -INFINITY, v2 = -INFINITY; int e1 = 0, e2 = 0;
                for (int e = 0; e < 8; ++e) { const float z = lg[4 + e] + args.b_re[gi * 8 + e];
                    if (z > v1) { v2 = v1; e2 = e1; v1 = z; e1 = e; } else if (z > v2) { v2 = z; e2 = e; } }
                const float t2 = expf(v2 - v1); const float w1 = gp / (1.f + t2), w2 = gp * t2 / (1.f + t2);
                const int lr = lrow0 + lane;
                peL[lr * 2] = gi * 8 + e1; peL[lr * 2 + 1] = gi * 8 + e2; pwL[lr * 2] = w1; pwL[lr * 2 + 1] = w2; }
            LDS_WAIT(); asm volatile("" ::: "memory");
        }
        __syncthreads();
        if (rep_ != REPS(6) - 1) continue;
        int my_e = 0, my_lr = 0;
        if (tid < 256) { my_e = peL[tid]; my_lr = __hip_atomic_fetch_add(lcount + my_e, 1, __ATOMIC_RELAXED, __HIP_MEMORY_SCOPE_WORKGROUP); }
        __syncthreads();
        if (tid < 32) { const int n = lcount[tid]; gbase[tid] = n ? (int)__hip_atomic_fetch_add(ctl + CW_CNT + tid * 16, (unsigned)n, RLX_AGENT) : 0; }
        __syncthreads();
        if (tid < 256) { const int slot = gbase[my_e] + my_lr; if (slot < LCAP) {
            __hip_atomic_store((unsigned*)TOKL + (size_t)my_e * LCAP + slot, (unsigned)((bx * 128 + (tid >> 1)) * 2 + (tid & 1)), RLX_AGENT);
            __hip_atomic_store((unsigned*)WLST + (size_t)my_e * LCAP + slot, __builtin_bit_cast(unsigned, (float)pwL[tid]), RLX_AGENT); } }
    }
    GRID_BAR(6);

    if (IN(7) || IN(8)) {
        __syncthreads();
        LAS int* cntL = (LAS int*)(L + MOE_CNT_OFF); LAS int* pbase = (LAS int*)(L + MOE_PB_OFF); LAS int* tokL = (LAS int*)(L + MOE_TOK_OFF);
        if (tid < 32) { int n = (int)__hip_atomic_load(ctl + CW_CNT + tid * 16, RLX_AGENT); cntL[tid] = n < LCAP ? n : LCAP; }
        __syncthreads();
        if (tid == 0) { int p = 0; for (int e = 0; e < 32; ++e) { pbase[e] = p; p += (cntL[e] + 255) >> 8; } pbase[32] = p; }
        __syncthreads();
        if (IN(7)) for (int rep_ = 0; rep_ < REPS(7); ++rep_) {
            pg8::MoeOrder S{pbase, 1, G, bx};
            { pg8::Unit u; for (int i = 0; i < 15 && S.next(i, u); ++i) { if (tid < 256) { const int slot = u.seg * 256 + tid; tokL[i * 256 + tid] = (slot < cntL[u.e]) ? TOKL[(size_t)u.e * LCAP + slot] : 0; } } }
            __syncthreads();
            pg8::SrcMoe1 src{(const char*)HB, (const char*)WGU, tokL, 1024};
            pg8::EpiHid E{WLST, cntL, HID};
            pg8::gemm_phase<pg8::EpiHid, pg8::MoeOrder, pg8::SrcMoe1, true>(L + RING_OFF, src, S, E);
        }
        GRID_BAR(7);
        if (IN(8)) for (int rep_ = 0; rep_ < REPS(8); ++rep_) {
            down_body::down_phase((char*)lds + RING_OFF, tokL, cntL, pbase, G, bx, HID, WD, TOKL, Y2, (bf16*)(ws + WS_DUMMY));
        }
    }
    GRID_BAR(8);

    if (IN(9)) for (int rep_ = 0; rep_ < REPS(9); ++rep_) {
        const int gw = bx * NWAVES + wave; const int row0 = gw * 16, b = row0 >> 12;
        const float* gf = MOD + b * 6144 + 5120;
        f32x4 g4[4], gn[4];
#pragma unroll
        for (int j = 0; j < 4; ++j) { g4[j] = *(const f32x4*)(gf + 4 * lane + 256 * j); gn[j] = *(const f32x4*)(args.g_final + 4 * lane + 256 * j); }
        for (int rr = 0; rr < 16; ++rr) { const int row = row0 + rr;
            const v2u* xr = (const v2u*)(X1 + (size_t)row * D) + lane;
            f32x4* xo = (f32x4*)(args.out + (size_t)row * D) + lane;
            const v2u* y0 = (const v2u*)(Y2 + (size_t)(2 * row) * D) + lane; const v2u* y1 = (const v2u*)(Y2 + (size_t)(2 * row + 1) * D) + lane;
            f32x4 v[4]; float ss = 0.f;
#pragma unroll
            for (int j = 0; j < 4; ++j) { const v2u a = y0[64 * j], c = y1[64 * j]; const f32x4 ya = {bflo(a.x), bfhi(a.x), bflo(a.y), bfhi(a.y)}, yc = {bflo(c.x), bfhi(c.x), bflo(c.y), bfhi(c.y)};
                const v2u xw = xr[64 * j]; v[j] = (f32x4){bflo(xw.x), bfhi(xw.x), bflo(xw.y), bfhi(xw.y)} + g4[j] * (ya + yc); ss += (v[j].x * v[j].x + v[j].y * v[j].y) + (v[j].z * v[j].z + v[j].w * v[j].w); }
            const float rstd = 1.0f / sqrtf(wave_sum(ss) * (1.f / D) + EPS);
#pragma unroll
            for (int j = 0; j < 4; ++j) __builtin_nontemporal_store(v[j] * rstd * gn[j], xo + 64 * j);
        }
    }
#undef IN
#undef GRID_BAR
}

extern "C" void kernel_launch(void* const* d_in, const int* in_sizes, int n_in, void* d_out, int out_size, void* d_ws, size_t ws_size, hipStream_t stream) {
    static int grid = 0;
    if (grid == 0) {
        if (n_in != 21 || in_sizes[0] != M * D || out_size != M * D || ws_size < WS_END) { fprintf(stderr, "kernel_launch: unexpected shapes (n_in %d, in0 %d, out %d, ws %zu); nothing launched\n", n_in, n_in > 0 ? in_sizes[0] : -1, out_size, ws_size); grid = -1; return; }
        int dev = 0, cus = 0;
        if (hipGetDevice(&dev) != hipSuccess || hipDeviceGetAttribute(&cus, hipDeviceAttributeMultiprocessorCount, dev) != hipSuccess) { grid = -1; return; }
        if (hipFuncSetAttribute((const void*)fwd_kernel, hipFuncAttributeMaxDynamicSharedMemorySize, LDS_BYTES) != hipSuccess) { fprintf(stderr, "kernel_launch: hipFuncSetAttribute failed\n"); grid = -1; return; }
        int per_cu = 0;
        if (hipOccupancyMaxActiveBlocksPerMultiprocessor(&per_cu, (const void*)fwd_kernel, NWAVES * 64, LDS_BYTES) != hipSuccess || per_cu < 1) fprintf(stderr, "kernel_launch: occupancy query reports %d\n", per_cu);
        (void)hipGetLastError();
        grid = cus;
        if (grid != 256) { fprintf(stderr, "kernel_launch: built for 256 CUs, device has %d; nothing launched\n", cus); grid = -1; return; }
    }
    if (grid < 0) return;
    if (hipMemsetAsync((char*)d_ws + WS_CTL, 0, CTL_ZERO_BYTES, stream) != hipSuccess) return;
    Args a{};
    const float** ap = (const float**)&a;
    for (int i = 0; i < 21; ++i) ap[i] = (const float*)d_in[i];
    a.out = (float*)d_out; a.ws = (unsigned char*)d_ws; a.ph_lo = 0; a.ph_hi = 10;
    hipLaunchKernelGGL(fwd_kernel, dim3(grid), dim3(NWAVES * 64), LDS_BYTES, stream, a);
}
```
